# Optimizing an MI355X kernel written in HIP

```python
import math
import jax, jax.numpy as jnp
from jax import lax
import numpy as np

D_MODEL = 1024
BATCH = 8
SEQ = 4096
DEPTH = 1

GRID_W = 64
CTX_LEN = 256
EPS = 1e-6
MIX_WIDTH = D_MODEL
MLA_HEADS = 8
MLA_NOPE = 64
MLA_ROPE = 32
MLA_V = 64
MLA_Q_RANK = 256
MLA_KV_RANK = 128
MLA_WIDTH = MLA_HEADS * MLA_V
LRU_WIDTH = MIX_WIDTH - MLA_WIDTH
LRU_BLOCKS = 8
LRU_BLOCK = LRU_WIDTH // LRU_BLOCKS
CONV_W = 4
CONV_LEFT = 2
RG_C = 8.0
ROPE_BASE = 10000.0
ROPE_AXIS = MLA_ROPE // 2
ATTN_SCALE = (MLA_NOPE + MLA_ROPE) ** -0.5
Q_BLOCK = 128
COL_Q = 0
COL_KV = COL_Q + MLA_Q_RANK
COL_KR = COL_KV + MLA_KV_RANK
COL_LRU_X = COL_KR + MLA_ROPE
COL_LRU_G = COL_LRU_X + LRU_WIDTH
IN_COLS = COL_LRU_G + LRU_WIDTH
N_EXPERTS = 64
TOP_K = 8
N_GROUPS = 8
TOPK_GROUPS = 4
EXPERT_FF = 256
SHARED_FF = 256
ROUTED_SCALE = 2.5
DISPATCH_BLOCK = 256

kernel_name = "hymba_mla_rglru_moe_dit_layer"


def rmsnorm(t, g):
    t32 = t.astype(jnp.float32)
    t32 = t32 * lax.rsqrt(jnp.mean(t32 * t32, axis=-1, keepdims=True) + EPS)
    return (t32 * g.astype(jnp.float32)).astype(t.dtype)


def modulate(t, shift, scale):
    return t * (1.0 + scale) + shift


def axial_rope_tables(n_tokens):
    rows = n_tokens // GRID_W
    row = jnp.repeat(jnp.arange(rows, dtype=jnp.float32), GRID_W)
    col = jnp.tile(jnp.arange(GRID_W, dtype=jnp.float32), rows)
    inv_freq = ROPE_BASE ** (-jnp.arange(0, ROPE_AXIS, 2, dtype=jnp.float32) / ROPE_AXIS)
    ang = jnp.stack([row, col], axis=-1)[:, :, None] * inv_freq
    return jnp.cos(ang)[:, None], jnp.sin(ang)[:, None]


def apply_axial_rope(t, cos, sin):
    b_, s_, h_, _ = t.shape
    t32 = t.astype(jnp.float32).reshape(b_, s_, h_, 2, 2, ROPE_AXIS // 2)
    t1, t2 = t32[..., 0, :], t32[..., 1, :]
    out = jnp.stack([t1 * cos - t2 * sin, t1 * sin + t2 * cos], axis=-2)
    return out.reshape(b_, s_, h_, MLA_ROPE).astype(t.dtype)


def mla_q(proj, q_norm_g, w_q_up):
    b_, l_, _ = proj.shape
    q = (rmsnorm(proj[..., COL_Q:COL_KV], q_norm_g) @ w_q_up).reshape(b_, l_, MLA_HEADS, MLA_NOPE + MLA_ROPE)
    return q[..., :MLA_NOPE], q[..., MLA_NOPE:]


def mla_kv(proj, kv_norm_g, w_kv_up):
    b_, l_, _ = proj.shape
    kv = (rmsnorm(proj[..., COL_KV:COL_KR], kv_norm_g) @ w_kv_up).reshape(b_, l_, MLA_HEADS, MLA_NOPE + MLA_V)
    k_rope = proj[..., COL_KR:COL_LRU_X][:, :, None, :]
    return kv[..., :MLA_NOPE], k_rope, kv[..., MLA_NOPE:]


def join_key(k_nope, k_rope):
    return jnp.concatenate([k_nope, jnp.broadcast_to(k_rope, k_nope.shape[:-1] + (MLA_ROPE,))], axis=-1)


def attend(q, k, v):
    s = jnp.einsum('bqhd,bkhd->bhqk', q, k, preferred_element_type=jnp.float32) * ATTN_SCALE
    p = jax.nn.softmax(s, axis=-1)
    return jnp.einsum('bhqk,bkhd->bqhd', p.astype(v.dtype), v)


def short_conv(u, w, b):
    l_ = u.shape[1]
    up = jnp.pad(u, ((0, 0), (CONV_LEFT, CONV_W - 1 - CONV_LEFT), (0, 0)))
    out = b
    for j in range(CONV_W):
        out = out + up[:, j:j + l_] * w[j]
    return out


def block_diag(u, w, b):
    ub = u.reshape(u.shape[:-1] + (LRU_BLOCKS, LRU_BLOCK))
    return jnp.einsum('blnc,ncd->blnd', ub, w).reshape(u.shape) + b


def rglru_coeffs(u, w_a, b_a, w_x, b_x, lam):
    r = jax.nn.sigmoid(block_diag(u, w_a, b_a).astype(jnp.float32))
    i = jax.nn.sigmoid(block_diag(u, w_x, b_x).astype(jnp.float32))
    log_a = -RG_C * r * jax.nn.softplus(-lam.astype(jnp.float32))
    a = jnp.exp(log_a)
    b = jnp.sqrt(-jnp.expm1(2.0 * log_a)) * (i * u.astype(jnp.float32))
    return a, b


def linear_scan(a, b, h0):
    b = b.at[:, 0].add(a[:, 0] * h0)

    def combine(left, right):
        return left[0] * right[0], right[0] * left[1] + right[1]

    return lax.associative_scan(combine, (a, b), axis=1)[1]


def rglru_bidirectional(u_lat, u_ctx, lru_w_a, lru_b_a, lru_w_x, lru_b_x, lru_lambda, need_ctx):
    ys_lat, ys_ctx = [], []
    for d in range(2):
        flip = (lambda t: t) if d == 0 else (lambda t: jnp.flip(t, axis=1))
        params = (lru_w_a[d], lru_b_a[d], lru_w_x[d], lru_b_x[d], lru_lambda[d])
        a_c, b_c = rglru_coeffs(flip(u_ctx), *params)
        h_c = linear_scan(a_c, b_c, jnp.zeros_like(b_c[:, 0]))
        a_l, b_l = rglru_coeffs(flip(u_lat), *params)
        h_l = linear_scan(a_l, b_l, h_c[:, -1])
        ys_lat.append(flip(h_l))
        if need_ctx:
            ys_ctx.append(flip(h_c))
    y_ctx = ys_ctx[0] + ys_ctx[1] if need_ctx else None
    return ys_lat[0] + ys_lat[1], y_ctx


def hybrid_mixer(h_lat, h_ctx, cos, sin, w_in, q_norm_g, w_q_up, kv_norm_g, w_kv_up,
                 conv_w, conv_b, lru_w_a, lru_b_a, lru_w_x, lru_b_x, lru_lambda, need_ctx):
    b_, s_, _ = h_lat.shape
    p_lat = h_lat @ w_in
    p_ctx = h_ctx @ w_in

    qn_l, qr_l = mla_q(p_lat, q_norm_g, w_q_up)
    kn_l, kr_l, v_l = mla_kv(p_lat, kv_norm_g, w_kv_up)
    kn_c, kr_c, v_c = mla_kv(p_ctx, kv_norm_g, w_kv_up)
    q_lat = jnp.concatenate([qn_l, apply_axial_rope(qr_l, cos, sin)], axis=-1)
    k_ctx = join_key(kn_c, kr_c)
    k_all = jnp.concatenate([join_key(kn_l, apply_axial_rope(kr_l, cos, sin)), k_ctx], axis=1)
    v_all = jnp.concatenate([v_l, v_c], axis=1)
    n_blk = s_ // Q_BLOCK
    q_blocks = jnp.moveaxis(q_lat.reshape(b_, n_blk, Q_BLOCK, MLA_HEADS, MLA_NOPE + MLA_ROPE), 1, 0)
    o_lat = lax.map(lambda qb: attend(qb, k_all, v_all), q_blocks)
    o_lat = jnp.moveaxis(o_lat, 0, 1).reshape(b_, s_, MLA_WIDTH)

    u_lat = short_conv(p_lat[..., COL_LRU_X:COL_LRU_G], conv_w, conv_b)
    u_ctx = short_conv(p_ctx[..., COL_LRU_X:COL_LRU_G], conv_w, conv_b)
    r_lat, r_ctx = rglru_bidirectional(u_lat, u_ctx, lru_w_a, lru_b_a, lru_w_x, lru_b_x, lru_lambda, need_ctx)
    g_lat = jax.nn.gelu(p_lat[..., COL_LRU_G:].astype(jnp.float32))
    y_lat = jnp.concatenate([o_lat, (r_lat * g_lat).astype(h_lat.dtype)], axis=-1)

    y_ctx = None
    if need_ctx:
        qn_c, qr_c = mla_q(p_ctx, q_norm_g, w_q_up)
        o_ctx = attend(jnp.concatenate([qn_c, qr_c], axis=-1), k_ctx, v_c).reshape(b_, -1, MLA_WIDTH)
        g_ctx = jax.nn.gelu(p_ctx[..., COL_LRU_G:].astype(jnp.float32))
        y_ctx = jnp.concatenate([o_ctx, (r_ctx * g_ctx).astype(h_ctx.dtype)], axis=-1)
    return y_lat, y_ctx


def swiglu(u, w_gate, w_up, w_down):
    return (jax.nn.silu(u @ w_gate) * (u @ w_up)) @ w_down


def routed_experts(h, eidx, w, exp_w_gate, exp_w_up, exp_w_down):
    t_, _ = h.shape
    n_assign = t_ * TOP_K
    n_blocks = n_assign // DISPATCH_BLOCK + N_EXPERTS
    e_flat = eidx.reshape(-1)
    tok_flat = jnp.repeat(jnp.arange(t_, dtype=jnp.int32), TOP_K)
    order = jnp.argsort(e_flat, stable=True)
    e_sorted = e_flat[order]
    counts = jnp.bincount(e_flat, length=N_EXPERTS)
    starts = jnp.cumsum(counts) - counts
    padded = (counts + DISPATCH_BLOCK - 1) // DISPATCH_BLOCK * DISPATCH_BLOCK
    pad_end = jnp.cumsum(padded)
    dest = pad_end[e_sorted] - padded[e_sorted] + (jnp.arange(n_assign, dtype=jnp.int32) - starts[e_sorted])
    slot_tok = jnp.zeros((n_blocks * DISPATCH_BLOCK,), jnp.int32).at[dest].set(tok_flat[order])
    slot_w = jnp.zeros((n_blocks * DISPATCH_BLOCK,), w.dtype).at[dest].set(w.reshape(-1)[order])
    blk_expert = jnp.minimum(
        jnp.searchsorted(pad_end, jnp.arange(n_blocks, dtype=jnp.int32) * DISPATCH_BLOCK, side='right'),
        N_EXPERTS - 1)

    def body(acc, blk):
        tok_b, w_b, e_b = blk
        y = swiglu(h[tok_b], exp_w_gate[e_b], exp_w_up[e_b], exp_w_down[e_b])
        return acc.at[tok_b].add(y * w_b[:, None]), None

    acc, _ = lax.scan(body, jnp.zeros_like(h),
                      (slot_tok.reshape(n_blocks, DISPATCH_BLOCK),
                       slot_w.reshape(n_blocks, DISPATCH_BLOCK), blk_expert))
    return acc


def moe_ffn(h, router_w, router_bias, exp_w_gate, exp_w_up, exp_w_down, sh_w_gate, sh_w_up, sh_w_down):
    t_, _ = h.shape
    scores = jax.nn.sigmoid(jnp.matmul(h, router_w, preferred_element_type=jnp.float32))
    sel = scores + router_bias.astype(jnp.float32)
    grp = sel.reshape(t_, N_GROUPS, N_EXPERTS // N_GROUPS)
    grp_score = lax.top_k(grp, 2)[0].sum(-1)
    _, gidx = lax.top_k(grp_score, TOPK_GROUPS)
    gmask = jax.nn.one_hot(gidx, N_GROUPS, dtype=jnp.float32).sum(1) > 0
    emask = jnp.repeat(gmask, N_EXPERTS // N_GROUPS, axis=1)
    _, eidx = lax.top_k(jnp.where(emask, sel, -jnp.inf), TOP_K)
    w = jnp.take_along_axis(scores, eidx, axis=1)
    w = ROUTED_SCALE * w / w.sum(-1, keepdims=True)
    routed = routed_experts(h, eidx, w.astype(h.dtype), exp_w_gate, exp_w_up, exp_w_down)
    return routed + swiglu(h, sh_w_gate, sh_w_up, sh_w_down)


def setup_inputs(seed: int = 0) -> dict:
    key = jax.random.key(seed)
    k = jax.random.split(key, 32)
    L, D = DEPTH, D_MODEL
    f32 = jnp.float32

    def dense(kk, shape, fan_in, gain=1.0):
        return (gain * fan_in ** -0.5) * jax.random.normal(kk, shape, f32)

    def norm_gain(kk, shape):
        return 1.0 + 0.05 * jax.random.normal(kk, shape, f32)

    def small(kk, shape, s=0.02):
        return s * jax.random.normal(kk, shape, f32)

    u = jax.random.uniform(k[19], (L, 2, LRU_WIDTH), f32, 0.9, 0.999)
    a_base = u ** (1.0 / RG_C)
    lru_lambda = jnp.log(a_base) - jnp.log1p(-a_base)
    return {
        "x": jax.random.normal(k[0], (BATCH, SEQ, D), f32),
        "c": jax.random.normal(k[1], (BATCH, D), f32),
        "ctx": jax.random.normal(k[2], (BATCH, CTX_LEN, D), f32),
        "c_ctx": jax.random.normal(k[3], (D,), f32),
        "w_mod": dense(k[4], (L, D, 6 * D), D, 0.5),
        "b_mod": small(k[5], (L, 6 * D)),
        "norm_mix_g": norm_gain(k[6], (L, D)),
        "w_in": dense(k[7], (L, D, IN_COLS), D),
        "q_norm_g": norm_gain(k[8], (L, MLA_Q_RANK)),
        "w_q_up": dense(k[9], (L, MLA_Q_RANK, MLA_HEADS * (MLA_NOPE + MLA_ROPE)), MLA_Q_RANK),
        "kv_norm_g": norm_gain(k[10], (L, MLA_KV_RANK)),
        "w_kv_up": dense(k[11], (L, MLA_KV_RANK, MLA_HEADS * (MLA_NOPE + MLA_V)), MLA_KV_RANK),
        "conv_w": dense(k[12], (L, CONV_W, LRU_WIDTH), CONV_W),
        "conv_b": small(k[13], (L, LRU_WIDTH)),
        "lru_w_a": dense(k[14], (L, 2, LRU_BLOCKS, LRU_BLOCK, LRU_BLOCK), LRU_BLOCK),
        "lru_b_a": small(k[15], (L, 2, LRU_WIDTH)),
        "lru_w_x": dense(k[16], (L, 2, LRU_BLOCKS, LRU_BLOCK, LRU_BLOCK), LRU_BLOCK),
        "lru_b_x": small(k[17], (L, 2, LRU_WIDTH)),
        "lru_lambda": lru_lambda,
        "w_out": dense(k[18], (L, MIX_WIDTH, D), MIX_WIDTH),
        "norm_ffn_g": norm_gain(k[20], (L, D)),
        "router_w": dense(k[21], (L, D, N_EXPERTS), D),
        "router_bias": small(k[22], (L, N_EXPERTS), 0.01),
        "exp_w_gate": dense(k[23], (L, N_EXPERTS, D, EXPERT_FF), D),
        "exp_w_up": dense(k[24], (L, N_EXPERTS, D, EXPERT_FF), D),
        "exp_w_down": dense(k[25], (L, N_EXPERTS, EXPERT_FF, D), EXPERT_FF),
        "sh_w_gate": dense(k[26], (L, D, SHARED_FF), D),
        "sh_w_up": dense(k[27], (L, D, SHARED_FF), D),
        "sh_w_down": dense(k[28], (L, SHARED_FF, D), SHARED_FF),
        "final_norm_g": norm_gain(k[29], (D,)),
    }


def reference(x, c, ctx, c_ctx, w_mod, b_mod, norm_mix_g, w_in, q_norm_g, w_q_up, kv_norm_g, w_kv_up,
              conv_w, conv_b, lru_w_a, lru_b_a, lru_w_x, lru_b_x, lru_lambda, w_out, norm_ffn_g,
              router_w, router_bias, exp_w_gate, exp_w_up, exp_w_down, sh_w_gate, sh_w_up, sh_w_down,
              final_norm_g):
    b_, s_, d_ = x.shape
    n_ctx = ctx.shape[1]
    cos, sin = axial_rope_tables(s_)
    for l in range(DEPTH):
        last = l == DEPTH - 1
        m_lat = jax.nn.silu(c) @ w_mod[l] + b_mod[l]
        m_ctx = jax.nn.silu(c_ctx) @ w_mod[l] + b_mod[l]
        sh1, sc1, g1, sh2, sc2, g2 = jnp.split(m_lat[:, None, :], 6, axis=-1)
        csh1, csc1, cg1, csh2, csc2, cg2 = jnp.split(m_ctx, 6)

        h_lat = modulate(rmsnorm(x, norm_mix_g[l]), sh1, sc1)
        h_ctx = modulate(rmsnorm(ctx, norm_mix_g[l]), csh1, csc1)
        y_lat, y_ctx = hybrid_mixer(h_lat, h_ctx, cos, sin, w_in[l], q_norm_g[l], w_q_up[l], kv_norm_g[l],
                                    w_kv_up[l], conv_w[l], conv_b[l], lru_w_a[l], lru_b_a[l], lru_w_x[l],
                                    lru_b_x[l], lru_lambda[l], not last)
        x = x + g1 * (y_lat @ w_out[l])
        if not last:
            ctx = ctx + cg1 * (y_ctx @ w_out[l])

        f_lat = modulate(rmsnorm(x, norm_ffn_g[l]), sh2, sc2).reshape(-1, d_)
        moe_args = (router_w[l], router_bias[l], exp_w_gate[l], exp_w_up[l], exp_w_down[l],
                    sh_w_gate[l], sh_w_up[l], sh_w_down[l])
        if last:
            x = x + g2 * moe_ffn(f_lat, *moe_args).reshape(b_, s_, d_)
        else:
            f_ctx = modulate(rmsnorm(ctx, norm_ffn_g[l]), csh2, csc2).reshape(-1, d_)
            out = moe_ffn(jnp.concatenate([f_lat, f_ctx], axis=0), *moe_args)
            x = x + g2 * out[:b_ * s_].reshape(b_, s_, d_)
            ctx = ctx + cg2 * out[b_ * s_:].reshape(b_, n_ctx, d_)
    return rmsnorm(x, final_norm_g)
```

```cpp
#include <hip/hip_runtime.h>
#include <hip/hip_cooperative_groups.h>
#include <cstdio>
#include <cstdint>
namespace cg = cooperative_groups;

#ifndef ABL
#define ABL 0
#endif
#ifndef REP
#define REP 0
#endif
#define M0CUT 0
#define REPEAT(bit) for (int rep_ = 0; rep_ < ((REP & (bit)) ? 2 : 1); ++rep_)


constexpr int B_ = 8, S_ = 4096, D_ = 1024, CTXL = 256;
constexpr int TL = B_ * S_, TC = B_ * CTXL, TA = TL + TC;
constexpr int NKEY = S_ + CTXL;
constexpr int NH = 8, DQK = 96, DV = 64;
constexpr float EPS = 1e-6f;
constexpr int NEXP = 64, TOPK = 8;
constexpr int HALF_T = TL / 2;
constexpr int RSLOTS = HALF_T * TOPK + NEXP * 256;
constexpr int RTILES = RSLOTS / 256;
constexpr int STILES = HALF_T / 256;

constexpr size_t MiB = 1u << 20;
constexpr size_t O_MOD = 0;
constexpr size_t O_ROPE = 256 * 1024;
constexpr size_t O_SP = O_ROPE + 4096;
constexpr size_t O_WLRU = 512 * 1024;
constexpr size_t O_SSQQ = 1 * MiB;
constexpr size_t O_SSQKV = 2 * MiB;
constexpr size_t O_AGG = 3 * MiB;
constexpr size_t O_RTE = 8 * MiB;
constexpr size_t O_RTW = 9 * MiB;
constexpr size_t O_HIST = 10 * MiB;
constexpr size_t O_CNT = 10 * MiB + 512 * 1024;
constexpr size_t O_SLOT = 11 * MiB;
constexpr size_t O_RANK = 13 * MiB;
constexpr size_t O_WRT = 15 * MiB;
constexpr size_t O_WIN = 16 * MiB;
constexpr size_t O_WQ = 19 * MiB;
constexpr size_t O_WKV = 19 * MiB + 512 * 1024;
constexpr size_t O_WO = 20 * MiB;
constexpr size_t O_WGU = 22 * MiB;
constexpr size_t O_WD = 87 * MiB;
constexpr size_t O_HN = 120 * MiB;
constexpr size_t O_PQ = 188 * MiB;
constexpr size_t O_PKV = 205 * MiB;
constexpr size_t O_PX = 222 * MiB;
constexpr size_t O_GG = 256 * MiB;
constexpr size_t O_Q = 288 * MiB;
constexpr size_t O_K = 336 * MiB;
constexpr size_t O_V = 387 * MiB;
constexpr size_t O_Y = 421 * MiB;
constexpr size_t O_F1 = 120 * MiB;
constexpr size_t O_HID = 152 * MiB;
constexpr size_t O_YS = 232 * MiB;
constexpr size_t O_YSH = O_YS + 128 * MiB;
constexpr size_t WS_NEED = 488 * MiB;
static_assert(O_PQ + (size_t)TA * 256 * 2 <= O_PKV && O_PKV + (size_t)TA * 256 * 2 <= O_PX && O_PX + (size_t)TA * 512 * 2 <= O_GG && O_GG + (size_t)TL * 512 * 2 <= O_Q && O_Q + (size_t)TL * 768 * 2 <= O_K &&
              O_K + (size_t)64 * NKEY * 96 * 2 <= O_V && O_V + (size_t)64 * NKEY * 64 * 2 <= O_Y && O_Y + (size_t)TL * 1024 * 2 <= WS_NEED && O_HN + (size_t)TA * 1024 * 2 <= O_PQ, "mixer map");
static_assert(O_F1 + (size_t)HALF_T * 1024 * 2 <= O_HID && O_HID + (size_t)(RSLOTS + HALF_T) * 256 * 2 <= O_YS && O_YS + (size_t)HALF_T * 8 * 1024 * 2 <= WS_NEED && O_WD + (size_t)65 * 1024 * 256 * 2 <= O_HN && O_WGU + (size_t)65 * 512 * 1024 * 2 <= O_WD, "moe map");

typedef unsigned short bf16_t;
typedef short bf16x8 __attribute__((ext_vector_type(8)));
typedef float f32x4 __attribute__((ext_vector_type(4)));
typedef float f32x2 __attribute__((ext_vector_type(2)));
typedef float f32x16 __attribute__((ext_vector_type(16)));
typedef unsigned u32x4 __attribute__((ext_vector_type(4)));
typedef unsigned u32x2 __attribute__((ext_vector_type(2)));
#define LAS __attribute__((address_space(3)))

__device__ __forceinline__ unsigned f2bf(float f) { unsigned u = __builtin_bit_cast(unsigned, f); return (u + 0x7fffu + ((u >> 16) & 1u)) >> 16; }
__device__ __forceinline__ unsigned pk2(float lo, float hi) { unsigned r; asm("v_cvt_pk_bf16_f32 %0, %1, %2" : "=v"(r) : "v"(lo), "v"(hi)); return r; }
__device__ __forceinline__ float bf2f(unsigned short h) { return __builtin_bit_cast(float, (unsigned)h << 16); }
__device__ __forceinline__ float wave_sum(float v) {
#pragma unroll
    for (int o = 1; o < 64; o <<= 1) v += __shfl_xor(v, o);
    return v;
}
__device__ __forceinline__ float sigmoidf_(float z) { return 1.f / (1.f + __expf(-z)); }

struct Args { const float* in[30]; float* out; unsigned char* ws; };

struct Ctx {
    LAS unsigned char* lds; unsigned char* ws; const float* const* in; float* out;
    int tid, lane, wave, bid, G, vcu;
};

constexpr size_t O_MODCNT = 14 * MiB + 24576;
constexpr size_t O_BAR = 14 * MiB;
#define XB_TMO      128
#define XB_XCNT(j)  (256  + 64 * (j))
#define XB_XSUB(j)  (1280 + 64 * (j))
#define XB_XGEN(j)  (2304 + 64 * (j))
#define XB_TOP      3328
#define XB_TOPGEN   3392
#define XCD_BAR_WORDS 3456
#define XB_SPIN_CAP (1u << 22)
__device__ __forceinline__ unsigned xb_ld(unsigned* p)              { return __hip_atomic_load(p, __ATOMIC_RELAXED, __HIP_MEMORY_SCOPE_AGENT); }
__device__ __forceinline__ unsigned xb_add(unsigned* p, unsigned v) { return __hip_atomic_fetch_add(p, v, __ATOMIC_RELAXED, __HIP_MEMORY_SCOPE_AGENT); }
__device__ __forceinline__ unsigned xb_xcc_id() { return (unsigned)__builtin_amdgcn_s_getreg((3 << 11) | 20) & 0xFu; }
#define XB_SPIN(cond, bar) do { unsigned _sp = 0; while (cond) { __builtin_amdgcn_s_sleep(1); \
    if ((++_sp & 255u) == 0u) { if (xb_ld(&(bar)[XB_TMO])) break; if (_sp > XB_SPIN_CAP) { atomicAdd(&(bar)[XB_TMO], 1u); break; } } } } while (0)
struct XcdBarrier { unsigned* bar; unsigned x; volatile LAS unsigned* st; };
__device__ __forceinline__ XcdBarrier xcd_barrier_post(unsigned* bar, volatile LAS unsigned* st) {
    XcdBarrier b; b.bar = bar; b.x = xb_xcc_id(); b.st = st;
    if (threadIdx.x == 0) (void)xb_add(&bar[XB_XCNT(b.x)], 1u);
    return b;
}
__device__ __forceinline__ void xcd_barrier_complete(unsigned* bar, unsigned x, unsigned& nloc, unsigned& nx) {
    const unsigned G = gridDim.x * gridDim.y * gridDim.z;
    unsigned sum, cnt, mine, sp = 0u;
    for (;;) {
        sum = 0u; cnt = 0u; mine = 0u;
#pragma unroll
        for (unsigned j = 0; j < 16; ++j) { const unsigned c = xb_ld(&bar[XB_XCNT(j)]); sum += c; cnt += (c > 0u) ? 1u : 0u; mine = (j == x) ? c : mine; }
        if (sum == G) break;
        __builtin_amdgcn_s_sleep(1);
        if ((++sp & 255u) == 0u) { if (xb_ld(&bar[XB_TMO])) break; if (sp > XB_SPIN_CAP) { atomicAdd(&bar[XB_TMO], 1u); break; } }
    }
    nloc = mine > 0u ? mine : 1u; nx = cnt > 0u ? cnt : 1u;
}
__device__ __forceinline__ void xcd_barrier(const XcdBarrier& b) {
    asm volatile("s_waitcnt vmcnt(0)" ::: "memory");
    __syncthreads();
    if (threadIdx.x == 0) {
        unsigned* bar = b.bar;
        __builtin_amdgcn_s_waitcnt(0);
        unsigned nloc = b.st[0], nx = b.st[1];
        if (nloc == 0u) { xcd_barrier_complete(bar, b.x, nloc, nx); b.st[0] = nloc; b.st[1] = nx; }
        const unsigned old = xb_add(&bar[XB_XSUB(b.x)], 1u);
        const unsigned gen = old / nloc;
        if (old + 1u == (gen + 1u) * nloc) {
            __builtin_amdgcn_fence(__ATOMIC_RELEASE, "agent");
            asm volatile("s_waitcnt vmcnt(0)" ::: "memory");
            const unsigned og = xb_add(&bar[XB_TOP], 1u);
            const unsigned tg = og / nx;
            if (og + 1u == (tg + 1u) * nx) xb_add(&bar[XB_TOPGEN], 1u);
            else XB_SPIN(xb_ld(&bar[XB_TOPGEN]) == tg, bar);
            __builtin_amdgcn_fence(__ATOMIC_ACQUIRE, "agent");
            xb_add(&bar[XB_XGEN(b.x)], 1u);
            asm volatile("s_waitcnt vmcnt(0)" ::: "memory");
        } else {
            XB_SPIN(xb_ld(&bar[XB_XGEN(b.x)]) == gen, bar);
            __builtin_amdgcn_fence(__ATOMIC_ACQUIRE, "agent");
            asm volatile("s_waitcnt vmcnt(0)" ::: "memory");
        }
    }
    __syncthreads();
}

__device__ __forceinline__ Ctx fresh(const Ctx& X) { Ctx Y = X; int t = threadIdx.x; asm volatile("" : "+v"(t)); Y.tid = t; Y.lane = t & 63; Y.wave = __builtin_amdgcn_readfirstlane(t >> 6); return Y; }
__device__ __forceinline__ void p0_mod(const Ctx& X0) { const Ctx X = fresh(X0);
    if (X.bid >= 96) return;
    const float* c = X.in[1]; const float* cctx = X.in[3]; const float* wmod = X.in[4]; const float* bmod = X.in[5];
    LAS float* s = (LAS float*)X.lds;
    LAS float* part = s + 9 * 1024;
    for (int i = X.tid; i < 9 * 1024; i += 512) { const float v = (i < 8192) ? c[i] : cctx[i - 8192]; s[i] = v / (1.f + __expf(-v)); }
    __syncthreads();
    const int col = X.bid * 64 + X.lane; float acc[9];
#pragma unroll
    for (int r = 0; r < 9; ++r) acc[r] = 0.f;
    const int k0 = X.wave * 128;
#pragma unroll 4
    for (int k = k0; k < k0 + 128; ++k) { const float w = wmod[(size_t)k * 6144 + col];
#pragma unroll
        for (int r = 0; r < 9; ++r) acc[r] += s[r * 1024 + k] * w; }
#pragma unroll
    for (int r = 0; r < 9; ++r) part[(X.wave * 9 + r) * 64 + X.lane] = acc[r];
    __syncthreads();
    float* mod = (float*)(X.ws + O_MOD);
    for (int i = X.tid; i < 9 * 64; i += 512) { const int r = i >> 6, l = i & 63; float v = bmod[X.bid * 64 + l];
        for (int w = 0; w < 8; ++w) v += part[(w * 9 + r) * 64 + l];
        mod[r * 6144 + X.bid * 64 + l] = v; }
    asm volatile("s_waitcnt vmcnt(0)" ::: "memory"); __syncthreads();
    if (X.tid == 0) { __builtin_amdgcn_fence(__ATOMIC_RELEASE, "agent"); asm volatile("s_waitcnt vmcnt(0)" ::: "memory");
        __hip_atomic_fetch_add((unsigned*)(X.ws + O_MODCNT), 1u, __ATOMIC_RELAXED, __HIP_MEMORY_SCOPE_AGENT); }
}
__device__ __forceinline__ void wait_mod(const Ctx& X) {
    if (X.tid == 0) { unsigned sp = 0; while (__hip_atomic_load((unsigned*)(X.ws + O_MODCNT), __ATOMIC_RELAXED, __HIP_MEMORY_SCOPE_AGENT) < 96u) { __builtin_amdgcn_s_sleep(2); if (++sp > (1u << 24)) break; }
        __builtin_amdgcn_fence(__ATOMIC_ACQUIRE, "agent"); asm volatile("s_waitcnt vmcnt(0)" ::: "memory"); }
    __syncthreads();
}
__device__ __forceinline__ int rope_int(int o) { const int ax = o >> 4, hf = (o >> 3) & 1, f = o & 7; return ax * 16 + f * 2 + hf; }
__device__ __forceinline__ int tr_dest(int mode, int n, int row_off) {
    if (mode == 0) return row_off + n;
    if (mode == 1) { if (n < 384) return n; if (n < 416) return 384 + rope_int(n - 384); if (n < 928) return 512 + (n - 416); return 1024 + (n - 928); }
    if (mode == 2) { const int h = n / 96, d = n % 96; return h * 96 + (d < 64 ? d : 64 + rope_int(d - 64)); }
    if (mode == 5) { const int c = n & 255; return row_off + (n & ~255) + ((c >> 3) & 1) * 128 + (c >> 4) * 8 + (c & 7); }
    const int j = n; return row_off + (j >> 7) * 256 + (mode == 4 ? 128 : 0) + (j & 127);
}
__device__ __forceinline__ void tr_item_ld(const float* W, int K, int N, bf16_t* WT, int ldk, int mode, int row_off, const float* kscale, LAS float* scr, int item, int lane) {
    const int nblk = N / 32, kb = item / nblk, nb = item % nblk, k0 = 64 * kb, n0 = 32 * nb;
    { const int kr = lane >> 3, nq = (lane & 7) * 4; f32x4 v[8];
#pragma unroll
        for (int i = 0; i < 8; ++i) v[i] = *(const f32x4*)(W + (size_t)(k0 + 8 * i + kr) * N + n0 + nq);
#pragma unroll
        for (int i = 0; i < 8; ++i) { const int kk = 8 * i + kr; f32x4 x = v[i]; if (kscale) x = x * kscale[k0 + kk];
            scr[kk * 33 + nq] = x.x; scr[kk * 33 + nq + 1] = x.y; scr[kk * 33 + nq + 2] = x.z; scr[kk * 33 + nq + 3] = x.w; } }
    asm volatile("s_waitcnt lgkmcnt(0)" ::: "memory");
    const int c = lane & 7;
#pragma unroll
    for (int j = 0; j < 4; ++j) { const int n = (lane >> 3) + 8 * j; const LAS float* s = scr + (8 * c) * 33 + n;
        u32x4 o; o.x = pk2(s[0 * 33], s[1 * 33]); o.y = pk2(s[2 * 33], s[3 * 33]); o.z = pk2(s[4 * 33], s[5 * 33]); o.w = pk2(s[6 * 33], s[7 * 33]);
        *(u32x4*)(WT + (size_t)tr_dest(mode, n0 + n, row_off) * ldk + k0 + 8 * c) = o; }
    asm volatile("s_waitcnt lgkmcnt(0)" ::: "memory");
}
__device__ __forceinline__ void tr_item(const float* W, int K, int N, bf16_t* WT, int mode, int row_off, const float* kscale, LAS float* scr, int item, int lane) { tr_item_ld(W, K, N, WT, K, mode, row_off, kscale, scr, item, lane); }
__device__ __forceinline__ void convert_experts(const Ctx& X0, int gw, int NGW) { const Ctx X = fresh(X0);
    LAS float* scr = (LAS float*)(X.lds + 65536 + X.wave * 8704); unsigned char* ws = X.ws;
    constexpr int I_G = 65 * 128;
    for (int it = gw; it < 3 * I_G; it += NGW) { const int kind = it / I_G, r = it % I_G, e = r >> 7;
        if (kind == 0) { const float* src = e < 64 ? X.in[23] + (size_t)e * 1024 * 256 : X.in[26]; tr_item(src, 1024, 256, (bf16_t*)(ws + O_WGU), 3, e * 512, nullptr, scr, r & 127, X.lane); }
        else if (kind == 1) { const float* src = e < 64 ? X.in[24] + (size_t)e * 1024 * 256 : X.in[27]; tr_item(src, 1024, 256, (bf16_t*)(ws + O_WGU), 4, e * 512, nullptr, scr, r & 127, X.lane); }
        else { const float* src = e < 64 ? X.in[25] + (size_t)e * 256 * 1024 : X.in[28]; tr_item(src, 256, 1024, (bf16_t*)(ws + O_WD), 5, e * 1024, nullptr, scr, r & 127, X.lane); } }
}
__device__ __forceinline__ void p0_weights(const Ctx& X0) { const Ctx X = fresh(X0);
    LAS float* scr = (LAS float*)(X.lds + 65536 + X.wave * 8704);
    const int gw = X.vcu * 8 + X.wave, NGW = X.G * 8;
    unsigned char* ws = X.ws;
    constexpr int I_IN = 16 * 45, I_Q = 4 * 24, I_KV = 2 * 32, I_O = 16 * 32, I_L = 64;
    constexpr int NIT = I_IN + I_Q + I_KV + I_O + I_L;
    for (int it = gw; it < NIT; it += NGW) {
        int r = it;
        if (r < I_IN) { tr_item(X.in[7], 1024, 1440, (bf16_t*)(ws + O_WIN), 1, 0, nullptr, scr, r, X.lane); continue; } r -= I_IN;
        if (r < I_Q) { tr_item(X.in[9], 256, 768, (bf16_t*)(ws + O_WQ), 2, 0, X.in[8], scr, r, X.lane); continue; } r -= I_Q;
        if (r < I_KV) { tr_item_ld(X.in[11], 128, 1024, (bf16_t*)(ws + O_WKV), 256, 0, 0, X.in[10], scr, r, X.lane); continue; } r -= I_KV;
        if (r < I_O) { tr_item(X.in[19], 1024, 1024, (bf16_t*)(ws + O_WO), 0, 0, nullptr, scr, r, X.lane); continue; } r -= I_O;
        { const int m = r >> 1, d = m >> 4, g = (m >> 3) & 1, n = m & 7;
          const float* src = (g == 0 ? X.in[14] : X.in[16]) + (size_t)(d * 8 + n) * 4096;
          tr_item(src, 64, 64, (bf16_t*)(ws + O_WLRU), 0, m * 64, nullptr, scr, r & 1, X.lane); }
    }
    const int gt = X.bid * 512 + X.tid;
    for (int i = gt; i < 64 * 1024; i += X.G * 512) { const float w = X.in[21][(size_t)(i & 1023) * 64 + (i >> 10)]; const unsigned hi = f2bf(w); const float r = w - bf2f((unsigned short)hi);
        ((bf16_t*)(ws + O_WRT))[i] = (bf16_t)hi; ((bf16_t*)(ws + O_WRT))[64 * 1024 + i] = (bf16_t)f2bf(r); }
    if (gt < 512) { const int pos = gt >> 3, f = gt & 7; const float inv = powf(10000.f, -(float)f / 8.f); const float a = (float)pos * inv;
        float* rt = (float*)(ws + O_ROPE); rt[gt * 2] = cosf(a); rt[gt * 2 + 1] = sinf(a); }
    else if (gt < 1536) { const int i = gt - 512; const float lam = X.in[18][i]; ((float*)(ws + O_SP))[i] = log1pf(expf(-lam)); }
    for (int i = gt; i < 1024 * 16; i += X.G * 512) *(u32x4*)((bf16_t*)(ws + O_WKV) + (size_t)(i >> 4) * 256 + 128 + (i & 15) * 8) = (u32x4){0u, 0u, 0u, 0u};
    for (int i = gt; i < 96 * 1024 / 8; i += X.G * 512) *(u32x4*)((bf16_t*)(ws + O_WIN) + (size_t)416 * 1024 + (size_t)i * 8) = (u32x4){0u, 0u, 0u, 0u};
}


namespace pg8 {
constexpr int BM = 256, BK = 64, HALF = 128, HTB = HALF * BK * 2, STAGE_BYTES = 8 * HTB;
__device__ __forceinline__ int lds_byte(int r, int c) { const int st = (r >> 4) * 2 + (c >> 5), rr = r & 15, cc = c & 31, ob = rr * 64 + cc * 2; return st * 1024 + (ob ^ (((ob >> 9) & 1) << 5)); }
__device__ __forceinline__ void stage_rc(int b, int& R, int& C) { const int st = b / 1024, sb = b % 1024, swz = sb ^ (((sb >> 9) & 1) << 5); R = (st >> 1) * 16 + swz / 64; C = (st & 1) * 32 + (swz % 64) / 2; }
__device__ __forceinline__ int perm32(int rho) { const int n = rho >> 4, i = rho & 15; return 8 * (i >> 2) + 4 * n + (i & 3); }
struct Unit { int pm, pn; };
struct Gemm { const bf16_t* A; const bf16_t* Bt; int K; };
__device__ __forceinline__ unsigned cvt_pk_bf16(float lo, float hi) { unsigned r; asm volatile("v_cvt_pk_bf16_f32 %0, %1, %2" : "=v"(r) : "v"(lo), "v"(hi)); return r; }
struct RowsIdent { __device__ __forceinline__ int row(int, const Unit& u, int h, int R) const { return u.pm * BM + h * HALF + R; } };
template <class Epi, class Sched, class ARows, bool ALIGN_EPI>
__device__ __forceinline__ void gemm_phase(LAS unsigned char* lds, const Gemm g, const Sched& S, const Epi& E, const ARows& AR) {
    int tid = threadIdx.x; asm volatile("" : "+v"(tid));
    const int wid = __builtin_amdgcn_readfirstlane(tid >> 6), lane = tid & 63, wr = wid >> 2, wc = wid & 3, fr = lane & 15, fq = lane >> 4;
    int K = g.K; asm volatile("" : "+s"(K)); const int nt = K / BK;
    int RA[2], CA[2]; unsigned voffB[2];
#pragma unroll
    for (int i = 0; i < 2; ++i) { int R, C; stage_rc(tid * 16 + i * 8192, R, C); const int Rb = Epi::PERM ? ((R & ~31) + perm32(R & 31)) : R;
        RA[i] = R; CA[i] = C; voffB[i] = (unsigned)(Rb * K + C) * 2u; }
    const size_t kstep = (size_t)(BK * 2);
    const size_t hstep = (size_t)HALF * K * 2;
    const size_t tstep = 2 * hstep;
    const unsigned ldsw = (unsigned)wid * 1024u;
    const int aoff = lds_byte(wr * 64 + fr, fq * 8), boff = lds_byte(wc * 32 + fr, fq * 8);
    const char* Abase = (const char*)g.A;
#define PG8_SA(b, h) (((b) * 2 + (h)) * HTB)
#define PG8_SB(b, h) ((4 + (b) * 2 + (h)) * HTB)
#define PG8_STAGE(bufoff, gbase, voff) do { _Pragma("unroll") for (int _i = 0; _i < 2; ++_i) \
        __builtin_amdgcn_global_load_lds((const unsigned*)((const char*)(gbase) + (voff)[_i]), (LAS unsigned*)(lds + (bufoff) + ldsw + _i * 8192), 16, 0, 0); } while (0)
#define PG8_STAGEA(bufoff, AO, kb) do { _Pragma("unroll") for (int _i = 0; _i < 2; ++_i) \
        __builtin_amdgcn_global_load_lds((const unsigned*)(Abase + (size_t)(AO)[_i] + (size_t)(kb)), (LAS unsigned*)(lds + (bufoff) + ldsw + _i * 8192), 16, 0, 0); } while (0)
#define PG8_LDA(dst, b, h) do { _Pragma("unroll") for (int m = 0; m < 4; ++m) _Pragma("unroll") for (int k = 0; k < 2; ++k) dst[m][k] = *(const LAS bf16x8*)(lds + PG8_SA(b, h) + aoff + m * 2048 + k * 1024); } while (0)
#define PG8_LDB(dst, b, h) do { _Pragma("unroll") for (int n = 0; n < 2; ++n) _Pragma("unroll") for (int k = 0; k < 2; ++k) dst[n][k] = *(const LAS bf16x8*)(lds + PG8_SB(b, h) + boff + n * 2048 + k * 1024); } while (0)
#define PG8_MMA(ai, bj, At, Bt) do { __builtin_amdgcn_s_setprio(1); _Pragma("unroll") for (int m = 0; m < 4; ++m) _Pragma("unroll") for (int n = 0; n < 2; ++n) _Pragma("unroll") for (int k = 0; k < 2; ++k) \
        acc[ai][bj][m][n] = __builtin_amdgcn_mfma_f32_16x16x32_bf16(Bt[n][k], At[m][k], acc[ai][bj][m][n], 0, 0, 0); __builtin_amdgcn_s_setprio(0); } while (0)
#define PG8_WAIT_V(n) asm volatile("s_waitcnt vmcnt(" #n ")" ::: "memory")
#define PG8_WAIT_L(n) asm volatile("s_waitcnt lgkmcnt(" #n ")" ::: "memory")
#define PG8_BAR __builtin_amdgcn_s_barrier()
#define PG8_SCHED __builtin_amdgcn_sched_barrier(0)
#define PG8_AOFFS(dst, ui_, u_) do { _Pragma("unroll") for (int _h = 0; _h < 2; ++_h) _Pragma("unroll") for (int _i = 0; _i < 2; ++_i) \
        dst[_h][_i] = (unsigned)AR.row(ui_, u_, _h, RA[_i]) * (unsigned)(K * 2) + (unsigned)(CA[_i] * 2); } while (0)
    Unit cur, nxt; int ui = 0;
    if (!S.next(0, cur)) return;
    f32x4 acc[2][2][4][2];
#pragma unroll
    for (int a = 0; a < 2; ++a)
#pragma unroll
        for (int b = 0; b < 2; ++b)
#pragma unroll
            for (int m = 0; m < 4; ++m)
#pragma unroll
                for (int n = 0; n < 2; ++n) acc[a][b][m][n] = (f32x4){0.f, 0.f, 0.f, 0.f};
    bf16x8 At[4][2], B0[2][2], B1[2][2];
    unsigned aoc[2][2], aon[2][2];
    PG8_AOFFS(aoc, 0, cur);
    const char* cB = (const char*)g.Bt + (size_t)cur.pn * tstep;
    PG8_STAGE(PG8_SB(0, 0), cB, voffB); PG8_STAGE(PG8_SB(0, 1), cB + hstep, voffB); PG8_STAGEA(PG8_SA(0, 0), aoc[0], 0); PG8_STAGEA(PG8_SA(0, 1), aoc[1], 0);
    if (wr == 1) PG8_BAR;
    PG8_WAIT_V(2); PG8_BAR;
    PG8_STAGE(PG8_SB(1, 0), cB + kstep, voffB); PG8_STAGEA(PG8_SA(1, 0), aoc[0], kstep); PG8_STAGE(PG8_SB(1, 1), cB + hstep + kstep, voffB);
    PG8_WAIT_V(6); PG8_BAR;
    for (;;) {
        const bool has_next = S.next(ui + 1, nxt);
        if (has_next) { PG8_AOFFS(aon, ui + 1, nxt); } else {
#pragma unroll
            for (int h = 0; h < 2; ++h)
#pragma unroll
                for (int i = 0; i < 2; ++i) aon[h][i] = aoc[h][i]; }
        const char* nB = has_next ? (const char*)g.Bt + (size_t)nxt.pn * tstep : cB;
#pragma unroll 1
        for (int t = 0; t < nt; t += 2) {
            const bool last = (t == nt - 2);
            const size_t k1 = (size_t)(t + 1) * kstep;
            const size_t k2 = last ? 0 : (size_t)(t + 2) * kstep, k3 = k2 + kstep;
            const char* b2 = last ? nB : cB + (size_t)(t + 2) * kstep; const char* b3 = b2 + kstep;
            unsigned a2o[2][2];
#pragma unroll
            for (int h = 0; h < 2; ++h)
#pragma unroll
                for (int i = 0; i < 2; ++i) a2o[h][i] = last ? aon[h][i] : aoc[h][i];
            PG8_LDB(B0, 0, 0); PG8_LDB(B1, 0, 1); PG8_SCHED; PG8_LDA(At, 0, 0); PG8_STAGEA(PG8_SA(1, 1), aoc[1], k1);
            PG8_WAIT_V(8); PG8_WAIT_L(0); PG8_BAR; PG8_MMA(0, 0, At, B0); PG8_MMA(0, 1, At, B1); PG8_BAR; PG8_SCHED;
            PG8_LDA(At, 0, 1); PG8_STAGE(PG8_SB(0, 0), b2, voffB); PG8_STAGE(PG8_SB(0, 1), b2 + hstep, voffB); PG8_STAGEA(PG8_SA(0, 0), a2o[0], k2);
            PG8_WAIT_V(8); PG8_WAIT_L(0); PG8_BAR; PG8_MMA(1, 0, At, B0); PG8_MMA(1, 1, At, B1); PG8_BAR; PG8_SCHED;
            PG8_LDB(B0, 1, 0); PG8_LDB(B1, 1, 1); PG8_SCHED; PG8_LDA(At, 1, 0); PG8_STAGEA(PG8_SA(0, 1), a2o[1], k2);
            PG8_WAIT_V(8); PG8_WAIT_L(0); PG8_BAR; PG8_MMA(0, 0, At, B0); PG8_MMA(0, 1, At, B1); PG8_BAR; PG8_SCHED;
            PG8_LDA(At, 1, 1); PG8_STAGE(PG8_SB(1, 0), b3, voffB); PG8_STAGE(PG8_SB(1, 1), b3 + hstep, voffB); PG8_STAGEA(PG8_SA(1, 0), a2o[0], k3);
            PG8_WAIT_V(8); PG8_WAIT_L(0); PG8_BAR; PG8_MMA(1, 0, At, B0); PG8_MMA(1, 1, At, B1); PG8_BAR; PG8_SCHED;
        }
        if constexpr (ALIGN_EPI) { if (wr == 0) PG8_BAR; }
        E(acc, cur, ui, wr, wc, fr, fq);
        if (!has_next) break;
#pragma unroll
        for (int a = 0; a < 2; ++a)
#pragma unroll
            for (int b = 0; b < 2; ++b)
#pragma unroll
                for (int m = 0; m < 4; ++m)
#pragma unroll
                    for (int n = 0; n < 2; ++n) acc[a][b][m][n] = (f32x4){0.f, 0.f, 0.f, 0.f};
        cur = nxt; cB = nB; ++ui;
#pragma unroll
        for (int h = 0; h < 2; ++h)
#pragma unroll
            for (int i = 0; i < 2; ++i) aoc[h][i] = aon[h][i];
        if constexpr (ALIGN_EPI) { if (wr == 1) PG8_BAR; }
    }
    PG8_WAIT_V(0);
    if constexpr (!ALIGN_EPI) { if (wr == 0) PG8_BAR; }
    PG8_BAR;
#undef PG8_SA
#undef PG8_SB
#undef PG8_STAGE
#undef PG8_STAGEA
#undef PG8_LDA
#undef PG8_LDB
#undef PG8_MMA
#undef PG8_WAIT_V
#undef PG8_WAIT_L
#undef PG8_BAR
#undef PG8_SCHED
#undef PG8_AOFFS
}
struct LinearOrder {
    int nM, nN, G, c;
    __device__ __forceinline__ bool next(int i, Unit& u) const { const int L = i * G + c; if (L >= nM * nN) return false; u.pm = L / nN; u.pn = L % nN; return true; }
};
struct InOrder {
    int G, c;
    __device__ __forceinline__ bool next(int i, Unit& u) const { const int L = i * G + c; if (L < 128 * 6) { u.pm = L / 6; u.pn = L % 6; return true; } const int r = L - 128 * 6; if (r >= 8 * 3) return false; u.pm = 128 + r / 3; u.pn = 1 + r % 3; return true; }
};
}


__device__ __forceinline__ void p1_norm(const Ctx& X0) { const Ctx X = fresh(X0);
    const int gw = X.bid * 8 + X.wave, NGW = X.G * 8; const float* g = X.in[6]; const float* mod = (const float*)(X.ws + O_MOD);
    bf16_t* HN = (bf16_t*)(X.ws + O_HN);
    for (int m0 = gw * 4; m0 < TA; m0 += NGW * 4) {
        const float* src = m0 < TL ? X.in[0] + (size_t)m0 * D_ : X.in[2] + (size_t)(m0 - TL) * D_;
        const float* md = mod + (size_t)(m0 < TL ? (m0 >> 12) : 8) * 6144;
        f32x4 v[4][4]; float ss[4];
#pragma unroll
        for (int rr = 0; rr < 4; ++rr) { const f32x4* xr = (const f32x4*)(src + (size_t)rr * D_) + X.lane;
#pragma unroll
            for (int j = 0; j < 4; ++j) v[rr][j] = xr[64 * j]; }
#pragma unroll
        for (int rr = 0; rr < 4; ++rr) { float s = 0.f;
#pragma unroll
            for (int j = 0; j < 4; ++j) s += (v[rr][j].x * v[rr][j].x + v[rr][j].y * v[rr][j].y) + (v[rr][j].z * v[rr][j].z + v[rr][j].w * v[rr][j].w);
            ss[rr] = s; }
#pragma unroll
        for (int o = 1; o < 64; o <<= 1) {
#pragma unroll
            for (int rr = 0; rr < 4; ++rr) ss[rr] += __shfl_xor(ss[rr], o); }
        float rstd[4];
#pragma unroll
        for (int rr = 0; rr < 4; ++rr) rstd[rr] = 1.f / sqrtf(ss[rr] * (1.f / D_) + EPS);
#pragma unroll
        for (int j = 0; j < 4; ++j) { const f32x4 gg = ((const f32x4*)g)[X.lane + 64 * j], sh = ((const f32x4*)md)[X.lane + 64 * j], sc = ((const f32x4*)(md + 1024))[X.lane + 64 * j]; const f32x4 gs = gg * (sc + 1.f);
#pragma unroll
            for (int rr = 0; rr < 4; ++rr) { const f32x4 h = v[rr][j] * rstd[rr] * gs + sh; u32x2 w; w.x = pk2(h.x, h.y); w.y = pk2(h.z, h.w); ((u32x2*)(HN + (size_t)(m0 + rr) * D_))[X.lane + 64 * j] = w; } }
    }
}
__device__ __forceinline__ float gelu_tanh(float v) { const float z = 0.7978845608028654f * (v + 0.044715f * v * v * v); const float t = 1.f - 2.f / (__expf(2.f * z) + 1.f); return 0.5f * v * (1.f + t); }

typedef f32x4 Acc[2][2][4][2];
struct EpiIn { static constexpr bool PERM = true;
    bf16_t *PQ, *PKV, *PX, *GG; float *SSQQ, *SSQKV;
    __device__ __forceinline__ void operator()(const Acc& acc, const pg8::Unit& u, int, int wr, int wc, int fr, int fq) const {
        const int pn = u.pn, row0 = u.pm * 256 + wr * 64 + fr, c0 = wc * 32 + 8 * fq;
#pragma unroll
        for (int ai = 0; ai < 2; ++ai)
#pragma unroll
            for (int m = 0; m < 4; ++m) { const int row = row0 + ai * 128 + m * 16; float ssq = 0.f;
#pragma unroll
                for (int bj = 0; bj < 2; ++bj) { f32x4 v0 = acc[ai][bj][m][0], v1 = acc[ai][bj][m][1]; const int col = bj * 128 + c0;
                    if (pn >= 4) { if (row >= TL) continue;
#pragma unroll
                        for (int e = 0; e < 4; ++e) { v0[e] = gelu_tanh(v0[e]); v1[e] = gelu_tanh(v1[e]); } }
                    u32x4 w; w.x = pk2(v0[0], v0[1]); w.y = pk2(v0[2], v0[3]); w.z = pk2(v1[0], v1[1]); w.w = pk2(v1[2], v1[3]);
                    if (pn < 2) { if (pn == 0 || bj == 0) {
#pragma unroll
                            for (int e = 0; e < 4; ++e) { const unsigned wd = e == 0 ? w.x : e == 1 ? w.y : e == 2 ? w.z : w.w; const float a = bf2f((unsigned short)(wd & 0xffffu)), b = bf2f((unsigned short)(wd >> 16)); ssq += a * a + b * b; } }
                        *(u32x4*)((pn == 0 ? PQ : PKV) + (size_t)row * 256 + col) = w; }
                    else if (pn < 4) *(u32x4*)(PX + (size_t)row * 512 + (pn - 2) * 256 + col) = w;
                    else *(u32x4*)(GG + (size_t)row * 512 + (pn - 4) * 256 + col) = w; }
                if (pn < 2) { ssq += __shfl_xor(ssq, 16); ssq += __shfl_xor(ssq, 32); if (fq == 0) (pn == 0 ? SSQQ : SSQKV)[(size_t)row * 4 + wc] = ssq; }
                asm volatile("" ::: "memory"); }
    }
};
constexpr float C2Q = 0.10206207261596577f * 1.4426950408889634f;
struct EpiQ { static constexpr bool PERM = true;
    bf16_t* Q; const float* SSQ; const float* ROPE;
    __device__ __forceinline__ void operator()(const Acc& acc, const pg8::Unit& u, int, int wr, int wc, int fr, int fq) const {
        const int row0 = u.pm * 256 + wr * 64 + fr; float rsv[2][4];
#pragma unroll
        for (int ai = 0; ai < 2; ++ai)
#pragma unroll
            for (int m = 0; m < 4; ++m) { const f32x4 sq = *(const f32x4*)(SSQ + (size_t)(row0 + ai * 128 + m * 16) * 4); rsv[ai][m] = C2Q / sqrtf(((sq.x + sq.y) + (sq.z + sq.w)) * (1.f / 256.f) + EPS); }
#pragma unroll
        for (int ai = 0; ai < 2; ++ai)
#pragma unroll
            for (int m = 0; m < 4; ++m) { const int row = row0 + ai * 128 + m * 16;
                const float rs = rsv[ai][m]; const int s = row & 4095;
#pragma unroll
                for (int bj = 0; bj < 2; ++bj) { const int c = u.pn * 256 + bj * 128 + wc * 32 + 8 * fq, d0 = c % 96; float v[8];
#pragma unroll
                    for (int e = 0; e < 4; ++e) { v[e] = acc[ai][bj][m][0][e] * rs; v[4 + e] = acc[ai][bj][m][1][e] * rs; }
                    if (d0 >= 64) { const int i0 = d0 - 64, pos = (i0 >> 4) == 0 ? (s >> 6) : (s & 63), f0 = (i0 & 15) >> 1; const float* rt = ROPE + (pos * 8 + f0) * 2;
#pragma unroll
                        for (int p = 0; p < 4; ++p) { const float cs = rt[2 * p], sn = rt[2 * p + 1], t1 = v[2 * p], t2 = v[2 * p + 1]; v[2 * p] = t1 * cs - t2 * sn; v[2 * p + 1] = t1 * sn + t2 * cs; } }
                    u32x4 w; w.x = pk2(v[0], v[1]); w.y = pk2(v[2], v[3]); w.z = pk2(v[4], v[5]); w.w = pk2(v[6], v[7]);
                    *(u32x4*)(Q + (size_t)row * 768 + c) = w; }
                asm volatile("" ::: "memory"); }
    }
};
struct EpiKV { static constexpr bool PERM = true;
    bf16_t *Kb, *Vb; const float* SSQ;
    __device__ __forceinline__ void operator()(const Acc& acc, const pg8::Unit& u, int, int wr, int wc, int fr, int fq) const {
        const int row0 = u.pm * 256 + wr * 64 + fr; float rsv[2][4];
#pragma unroll
        for (int ai = 0; ai < 2; ++ai)
#pragma unroll
            for (int m = 0; m < 4; ++m) { const f32x4 sq = *(const f32x4*)(SSQ + (size_t)(row0 + ai * 128 + m * 16) * 4); rsv[ai][m] = 1.f / sqrtf(((sq.x + sq.y) + (sq.z + sq.w)) * (1.f / 128.f) + EPS); }
#pragma unroll
        for (int ai = 0; ai < 2; ++ai)
#pragma unroll
            for (int m = 0; m < 4; ++m) { const int row = row0 + ai * 128 + m * 16;
                const float rs = rsv[ai][m];
                int b, key; if (row < TL) { b = row >> 12; key = row & 4095; } else { const int rr = row - TL; b = rr >> 8; key = 4096 + (rr & 255); }
#pragma unroll
                for (int bj = 0; bj < 2; ++bj) { const int c = u.pn * 256 + bj * 128 + wc * 32 + 8 * fq, h = c >> 7, j0 = c & 127; const f32x4 v0 = acc[ai][bj][m][0] * rs, v1 = acc[ai][bj][m][1] * rs;
                    u32x4 w; w.x = pk2(v0[0], v0[1]); w.y = pk2(v0[2], v0[3]); w.z = pk2(v1[0], v1[1]); w.w = pk2(v1[2], v1[3]);
                    const size_t bhk = (size_t)(b * 8 + h) * NKEY + key;
                    if (j0 < 64) *(u32x4*)(Kb + bhk * 96 + j0) = w; else *(u32x4*)(Vb + bhk * 64 + (j0 - 64)) = w; }
                asm volatile("" ::: "memory"); }
    }
};
struct EpiOut { static constexpr bool PERM = false;
    const float* x; float* out; const float* mod;
    __device__ __forceinline__ void operator()(const Acc& acc, const pg8::Unit& u, int, int wr, int wc, int fr, int fq) const {
        const int row0 = u.pm * 256 + wr * 64 + fr, col0 = u.pn * 256 + wc * 32 + 4 * fq;
        const float* g1 = mod + (size_t)((u.pm * 256) >> 12) * 6144 + 2048; f32x4 gv[2][2];
#pragma unroll
        for (int bj = 0; bj < 2; ++bj)
#pragma unroll
            for (int n = 0; n < 2; ++n) gv[bj][n] = *(const f32x4*)(g1 + col0 + bj * 128 + n * 16);
        f32x4 xn[2][2];
#pragma unroll
        for (int bj = 0; bj < 2; ++bj)
#pragma unroll
            for (int n = 0; n < 2; ++n) xn[bj][n] = *(const f32x4*)(x + (size_t)row0 * D_ + col0 + bj * 128 + n * 16);
#pragma unroll
        for (int ai = 0; ai < 2; ++ai)
#pragma unroll
            for (int m = 0; m < 4; ++m) { const int row = row0 + ai * 128 + m * 16; f32x4 xc[2][2];
#pragma unroll
                for (int bj = 0; bj < 2; ++bj)
#pragma unroll
                    for (int n = 0; n < 2; ++n) xc[bj][n] = xn[bj][n];
                if (ai * 4 + m < 7) { const int rown = row0 + ((ai * 4 + m + 1) >> 2) * 128 + ((ai * 4 + m + 1) & 3) * 16;
#pragma unroll
                    for (int bj = 0; bj < 2; ++bj)
#pragma unroll
                        for (int n = 0; n < 2; ++n) xn[bj][n] = *(const f32x4*)(x + (size_t)rown * D_ + col0 + bj * 128 + n * 16); }
#pragma unroll
                for (int bj = 0; bj < 2; ++bj)
#pragma unroll
                    for (int n = 0; n < 2; ++n) *(f32x4*)(out + (size_t)row * D_ + col0 + bj * 128 + n * 16) = xc[bj][n] + gv[bj][n] * acc[ai][bj][m][n];
                asm volatile("" ::: "memory"); }
    }
};
struct EpiHid { static constexpr bool PERM = true;
    bf16_t* HID;
    __device__ __forceinline__ void operator()(const Acc& acc, const pg8::Unit& u, int, int wr, int wc, int fr, int fq) const {
        const int row0 = u.pm * 256 + wr * 64 + fr, pl = u.pn & 1;
#pragma unroll
        for (int ai = 0; ai < 2; ++ai)
#pragma unroll
            for (int m = 0; m < 4; ++m) { const int row = row0 + ai * 128 + m * 16; float h[8];
#pragma unroll
                for (int n = 0; n < 2; ++n)
#pragma unroll
                    for (int e = 0; e < 4; ++e) { const float g = acc[ai][0][m][n][e], up = acc[ai][1][m][n][e]; h[n * 4 + e] = g * __builtin_amdgcn_rcpf(1.f + __builtin_amdgcn_exp2f(-1.4426950408889634f * g)) * up; }
                u32x4 w; w.x = pk2(h[0], h[1]); w.y = pk2(h[2], h[3]); w.z = pk2(h[4], h[5]); w.w = pk2(h[6], h[7]);
                *(u32x4*)(HID + (size_t)row * 256 + pl * 128 + wc * 32 + fq * 8) = w;
                asm volatile("" ::: "memory"); }
    }
};
constexpr float YSCALE = 16.f;
struct EpiDown { static constexpr bool PERM = true;
    unsigned char* YS; const LAS int* SLOT; float* out; const float* mod; int half; int noshared;
    __device__ __forceinline__ void operator()(const Acc& acc, const pg8::Unit& u, int ui, int wr, int wc, int fr, int fq) const {
        const int r0 = wr * 64 + fr, nl = u.pn & 3, c16 = nl * 256 + 16 * (4 * wc + fq); const bool shared = u.pm >= RTILES;
        int dsts[2][4];
#pragma unroll
        for (int ai = 0; ai < 2; ++ai)
#pragma unroll
            for (int m = 0; m < 4; ++m) dsts[ai][m] = SLOT[ui * 256 + r0 + ai * 128 + m * 16];
#pragma unroll
        for (int ai = 0; ai < 2; ++ai)
#pragma unroll
            for (int m = 0; m < 4; ++m) { const int r = r0 + ai * 128 + m * 16;
                if (!shared) { const int dst = dsts[ai][m]; if (dst >= 0 && !(noshared && (REP & 4096))) { u32x4 w; unsigned wd[4];
#pragma unroll
                        for (int bj = 0; bj < 2; ++bj)
#pragma unroll
                            for (int n = 0; n < 2; ++n) { const f32x4 v = acc[ai][bj][m][n] * YSCALE; int p = __builtin_amdgcn_cvt_pk_fp8_f32(v[0], v[1], 0, false); p = __builtin_amdgcn_cvt_pk_fp8_f32(v[2], v[3], p, true); wd[bj * 2 + n] = (unsigned)p; }
                        w.x = wd[0]; w.y = wd[1]; w.z = wd[2]; w.w = wd[3];
                        *(u32x4*)(YS + (size_t)dst * D_ + c16) = w; } }
                else { const int lt = (u.pm - RTILES) * 256 + r; bf16_t* p = (bf16_t*)(YS + (size_t)128 * MiB) + (size_t)lt * D_ + c16;
#pragma unroll
                    for (int bj = 0; bj < 2; ++bj) { const f32x4 v0 = acc[ai][bj][m][0], v1 = acc[ai][bj][m][1]; u32x4 w; w.x = pk2(v0[0], v0[1]); w.y = pk2(v0[2], v0[3]); w.z = pk2(v1[0], v1[1]); w.w = pk2(v1[2], v1[3]);
                        if (ABL & 8) w = (u32x4){0u, 0u, 0u, 0u};
                        *(u32x4*)(p + 8 * bj) = w; } }
                asm volatile("" ::: "memory"); }
    }
};
struct MoeOrder { const int* cnt; int half, nn, G, c;
    __device__ __forceinline__ bool next(int i, pg8::Unit& u) const { const int ntr = cnt[half]; const int L = i * G + c; if (L >= (ntr + STILES) * nn) return false;
        const int mt = L / nn, n = L % nn; int e;
        if (mt < ntr) { u.pm = mt; e = cnt[64 + half * 704 + mt]; } else { u.pm = RTILES + (mt - ntr); e = 64; }
        u.pn = e * nn + n; return true; }
};
struct RowsGather { const LAS int* tab;
    __device__ __forceinline__ int row(int ui, const pg8::Unit&, int h, int R) const { return tab[ui * 256 + h * 128 + R]; } };


__device__ __forceinline__ void krope_job(const Ctx& X0) { const Ctx X = fresh(X0);
    const bf16_t* PKV = (const bf16_t*)(X.ws + O_PKV); bf16_t* Kb = (bf16_t*)(X.ws + O_K); const float* ROPE = (const float*)(X.ws + O_ROPE);
    for (int it = X.bid * 512 + X.tid; it < TA * 4; it += X.G * 512) {
        const int row = it >> 2, q = it & 3, i0 = q * 8;
        const u32x4 w = *(const u32x4*)(PKV + (size_t)row * 256 + 128 + i0);
        float v[8]; v[0] = bf2f(w.x & 0xffff); v[1] = bf2f(w.x >> 16); v[2] = bf2f(w.y & 0xffff); v[3] = bf2f(w.y >> 16); v[4] = bf2f(w.z & 0xffff); v[5] = bf2f(w.z >> 16); v[6] = bf2f(w.w & 0xffff); v[7] = bf2f(w.w >> 16);
        int b, key;
        if (row < TL) { b = row >> 12; key = row & 4095; const int s = key, pos = (i0 >> 4) == 0 ? (s >> 6) : (s & 63), f0 = (i0 & 15) >> 1; const float* rt = ROPE + (pos * 8 + f0) * 2;
#pragma unroll
            for (int p = 0; p < 4; ++p) { const float cs = rt[2 * p], sn = rt[2 * p + 1], t1 = v[2 * p], t2 = v[2 * p + 1]; v[2 * p] = t1 * cs - t2 * sn; v[2 * p + 1] = t1 * sn + t2 * cs; } }
        else { const int rr = row - TL; b = rr >> 8; key = 4096 + (rr & 255); }
        u32x4 o; o.x = pk2(v[0], v[1]); o.y = pk2(v[2], v[3]); o.z = pk2(v[4], v[5]); o.w = pk2(v[6], v[7]);
#pragma unroll
        for (int h = 0; h < 8; ++h) *(u32x4*)(Kb + ((size_t)(b * 8 + h) * NKEY + key) * 96 + 64 + i0) = o;
    }
}

namespace att {
typedef short s16x4 __attribute__((ext_vector_type(4)));
constexpr int KROW = 208, SHM_V = 8192, SHM_K = 64 * KROW, BUFB = SHM_V + SHM_K, OFF_WS = 3 * BUFB;
#define SBAR() __builtin_amdgcn_sched_barrier(0)
__device__ __forceinline__ int crow(int r, int hi) { return (r & 3) + 8 * (r >> 2) + 4 * hi; }
__device__ __forceinline__ unsigned cvtpk(float lo, float hi) { unsigned r; asm volatile("v_cvt_pk_bf16_f32 %0, %1, %2" : "=v"(r) : "v"(lo), "v"(hi)); return r; }
constexpr float THR = 8.f;
__device__ __forceinline__ void partialSM(f32x16& p0, f32x16& p1, float& m_reg, float& mn, float& alpha) {
    float pmax = p0[0];
#pragma unroll
    for (int r = 1; r < 16; ++r) pmax = fmaxf(pmax, p0[r]);
#pragma unroll
    for (int r = 0; r < 16; ++r) pmax = fmaxf(pmax, p1[r]);
    { auto rr = __builtin_amdgcn_permlane32_swap(__float_as_uint(pmax), __float_as_uint(pmax), false, false); pmax = fmaxf(__uint_as_float(rr[0]), __uint_as_float(rr[1])); }
    if (__builtin_expect(__all(pmax - m_reg <= THR), 1)) { mn = m_reg; alpha = 1.f; }
    else { mn = fmaxf(m_reg, pmax); alpha = __builtin_amdgcn_exp2f(m_reg - mn); m_reg = mn; }
#pragma unroll
    for (int r = 0; r < 16; ++r) { p0[r] -= mn; p1[r] -= mn; }
#pragma unroll
    for (int r = 0; r < 16; ++r) p0[r] = __builtin_amdgcn_exp2f(p0[r]);
}
__device__ __forceinline__ void finishSM(f32x16& p0, f32x16& p1, float alpha, float& l_reg, bf16x8& pa0, bf16x8& pa1, bf16x8& pa2, bf16x8& pa3) {
#pragma unroll
    for (int r = 0; r < 16; ++r) p1[r] = __builtin_amdgcn_exp2f(p1[r]);
    float ps = 0;
#pragma unroll
    for (int r = 0; r < 16; ++r) ps += p0[r];
#pragma unroll
    for (int r = 0; r < 16; ++r) ps += p1[r];
    { auto rr = __builtin_amdgcn_permlane32_swap(__float_as_uint(ps), __float_as_uint(ps), false, false); ps = __uint_as_float(rr[0]) + __uint_as_float(rr[1]); }
    l_reg = l_reg * alpha + ps;
#define PK4(P, BASE, OUT) do { unsigned a0 = cvtpk(P[BASE + 0], P[BASE + 1]), a1 = cvtpk(P[BASE + 2], P[BASE + 3]);   \
    unsigned b0 = cvtpk(P[BASE + 4], P[BASE + 5]), b1 = cvtpk(P[BASE + 6], P[BASE + 7]);                              \
    auto r0 = __builtin_amdgcn_permlane32_swap(a0, b0, false, false); auto r1 = __builtin_amdgcn_permlane32_swap(a1, b1, false, false); \
    u32x4 w = {r0[0], r1[0], r0[1], r1[1]}; OUT = *reinterpret_cast<bf16x8*>(&w); } while (0)
    PK4(p0, 0, pa0); PK4(p0, 8, pa1); PK4(p1, 0, pa2); PK4(p1, 8, pa3);
#undef PK4
}
__device__ __forceinline__ void qkt(f32x16& p0, f32x16& p1, const char* Ks, const bf16x8* qr, int r32, int hi) {
    p0 = f32x16{}; p1 = f32x16{};
#pragma unroll
    for (int d0 = 0; d0 < 6; ++d0) { const int cb = (d0 * 16 + hi * 8) * 2;
        const bf16x8 b0 = *reinterpret_cast<const bf16x8*>(Ks + r32 * KROW + cb);
        const bf16x8 b1 = *reinterpret_cast<const bf16x8*>(Ks + (32 + r32) * KROW + cb);
        p0 = __builtin_amdgcn_mfma_f32_32x32x16_bf16(b0, qr[d0], p0, 0, 0, 0);
        p1 = __builtin_amdgcn_mfma_f32_32x32x16_bf16(b1, qr[d0], p1, 0, 0, 0); }
}
__device__ __forceinline__ int v_st(int k, int c) { const int kk = (k & ~0xC) | ((k & 4) << 1) | ((k & 8) >> 1); return ((kk >> 3) * 2 + (c >> 5)) * 512 + ((kk & 7) * 32 + (c & 31)) * 2; }
__device__ __forceinline__ int v_rd_base(int lane) { return ((lane & 3) << 3) | (((lane >> 2) & 3) << 6) | (((lane >> 4) & 1) << 5) | (((lane >> 5) & 1) << 8); }
constexpr int v_rd_off(int d0, int ks, int half) { return d0 * 512 + ks * 2048 + half * 1024; }
typedef short v4i16_t __attribute__((ext_vector_type(4)));
template <int OFF> __device__ __forceinline__ s16x4 tr_read(int vb) { return __builtin_bit_cast(s16x4, __builtin_amdgcn_ds_read_tr16_b64_v4i16((LAS v4i16_t*)(uintptr_t)(unsigned)(vb + OFF))); }
template <int D0> __device__ __forceinline__ void pv_one(f32x16& od, int vb, bf16x8 pa0, bf16x8 pa1, bf16x8 pa2, bf16x8 pa3) {
    const s16x4 l0 = tr_read<v_rd_off(D0, 0, 0)>(vb), h0 = tr_read<v_rd_off(D0, 0, 1)>(vb), l1 = tr_read<v_rd_off(D0, 1, 0)>(vb), h1 = tr_read<v_rd_off(D0, 1, 1)>(vb);
    const s16x4 l2 = tr_read<v_rd_off(D0, 2, 0)>(vb), h2 = tr_read<v_rd_off(D0, 2, 1)>(vb), l3 = tr_read<v_rd_off(D0, 3, 0)>(vb), h3 = tr_read<v_rd_off(D0, 3, 1)>(vb);
#define PK(L, H) (bf16x8){L[0], L[1], L[2], L[3], H[0], H[1], H[2], H[3]}
    od = __builtin_amdgcn_mfma_f32_32x32x16_bf16(pa0, PK(l0, h0), od, 0, 0, 0);
    od = __builtin_amdgcn_mfma_f32_32x32x16_bf16(pa1, PK(l1, h1), od, 0, 0, 0);
    od = __builtin_amdgcn_mfma_f32_32x32x16_bf16(pa2, PK(l2, h2), od, 0, 0, 0);
    od = __builtin_amdgcn_mfma_f32_32x32x16_bf16(pa3, PK(l3, h3), od, 0, 0, 0);
#undef PK
}
template <int D0> __device__ __forceinline__ void pv_joint(f32x16& oa, f32x16& ob, int vb, const bf16x8 (&pa)[2][4]) {
    const s16x4 l0 = tr_read<v_rd_off(D0, 0, 0)>(vb), h0 = tr_read<v_rd_off(D0, 0, 1)>(vb), l1 = tr_read<v_rd_off(D0, 1, 0)>(vb), h1 = tr_read<v_rd_off(D0, 1, 1)>(vb);
    const s16x4 l2 = tr_read<v_rd_off(D0, 2, 0)>(vb), h2 = tr_read<v_rd_off(D0, 2, 1)>(vb), l3 = tr_read<v_rd_off(D0, 3, 0)>(vb), h3 = tr_read<v_rd_off(D0, 3, 1)>(vb);
#define PK(L, H) (bf16x8){L[0], L[1], L[2], L[3], H[0], H[1], H[2], H[3]}
    const bf16x8 v0 = PK(l0, h0), v1 = PK(l1, h1), v2 = PK(l2, h2), v3 = PK(l3, h3);
    oa = __builtin_amdgcn_mfma_f32_32x32x16_bf16(pa[0][0], v0, oa, 0, 0, 0); ob = __builtin_amdgcn_mfma_f32_32x32x16_bf16(pa[1][0], v0, ob, 0, 0, 0);
    oa = __builtin_amdgcn_mfma_f32_32x32x16_bf16(pa[0][1], v1, oa, 0, 0, 0); ob = __builtin_amdgcn_mfma_f32_32x32x16_bf16(pa[1][1], v1, ob, 0, 0, 0);
    oa = __builtin_amdgcn_mfma_f32_32x32x16_bf16(pa[0][2], v2, oa, 0, 0, 0); ob = __builtin_amdgcn_mfma_f32_32x32x16_bf16(pa[1][2], v2, ob, 0, 0, 0);
    oa = __builtin_amdgcn_mfma_f32_32x32x16_bf16(pa[0][3], v3, oa, 0, 0, 0); ob = __builtin_amdgcn_mfma_f32_32x32x16_bf16(pa[1][3], v3, ob, 0, 0, 0);
#undef PK
}
__device__ __forceinline__ void pv_d0(f32x16* o, int vb, bf16x8 pa0, bf16x8 pa1, bf16x8 pa2, bf16x8 pa3) { pv_one<0>(o[0], vb, pa0, pa1, pa2, pa3); pv_one<1>(o[1], vb, pa0, pa1, pa2, pa3); }

__device__ __forceinline__ void unit(const bf16_t* __restrict__ Qb, const bf16_t* __restrict__ Kh, const bf16_t* __restrict__ Vh, bf16_t* __restrict__ Ob, char* lds) {
    int tid = threadIdx.x; asm volatile("" : "+v"(tid));
    const int wid = tid >> 6, lane = tid & 63, r32 = lane & 31, hi = lane >> 5;
    float* ws = (float*)(lds + OFF_WS) + wid * 64; float* li_l = ws; float* al_l = ws + 32;
    float m_reg = -1e30f, l_reg = 0; f32x16 o[2] = {}; bf16x8 qr[6];
    const bf16_t* Qw = Qb + (size_t)(wid * 32 + r32) * 768 + hi * 8;
#pragma unroll
    for (int d0 = 0; d0 < 6; ++d0) qr[d0] = *reinterpret_cast<const bf16x8*>(Qw + d0 * 16);
    const int vst = v_st(tid >> 3, (tid & 7) * 8);
    const int kc0 = tid, kc1 = 512 + tid; const bool k2 = tid < 256;
    const int kst0 = (kc0 / 12) * KROW + (kc0 % 12) * 16, kst1 = (kc1 / 12) * KROW + (kc1 % 12) * 16;
    const int vb0 = (int)(uintptr_t)lds + v_rd_base(lane);
    struct { bf16x8 vs, ks0, ks1; } sr_;
#define SLOAD(k0) do { sr_.vs = *reinterpret_cast<const bf16x8*>(Vh + (size_t)(k0) * 64 + tid * 8); \
    sr_.ks0 = *reinterpret_cast<const bf16x8*>(Kh + (size_t)(k0) * 96 + kc0 * 8); \
    if (k2) sr_.ks1 = *reinterpret_cast<const bf16x8*>(Kh + (size_t)(k0) * 96 + kc1 * 8); } while (0)
#define SWRITE(bo) do { *(bf16x8*)(lds + (bo) + vst) = sr_.vs; *(bf16x8*)(lds + (bo) + SHM_V + kst0) = sr_.ks0; \
    if (k2) *(bf16x8*)(lds + (bo) + SHM_V + kst1) = sr_.ks1; } while (0)
#define RESC(a) do { if (__any((a) < 1.f)) { if (hi == 0) al_l[r32] = (a); asm volatile("s_waitcnt lgkmcnt(0)" ::: "memory"); \
    _Pragma("unroll") for (int d = 0; d < 2; ++d) _Pragma("unroll") for (int r = 0; r < 16; ++r) o[d][r] *= al_l[crow(r, hi)]; } } while (0)
#define NEXTB(x) ((x) == 2 * BUFB ? 0 : (x) + BUFB)
    f32x16 pA0, pA1, pB0, pB1; float mnA, mnB, alA, alB; bf16x8 pa0, pa1, pa2, pa3; constexpr int NT = NKEY / 64;
    SLOAD(0); asm volatile("s_waitcnt vmcnt(0)" ::: "memory"); SWRITE(0); SLOAD(64); __syncthreads();
    SWRITE(BUFB); SLOAD(128);
    qkt(pA0, pA1, lds + SHM_V, qr, r32, hi); partialSM(pA0, pA1, m_reg, mnA, alA);
    __syncthreads();
    int bprev = 0, bcur = BUFB, bnext = 2 * BUFB;
    for (int j = 1; j + 1 < NT; j += 2) {
        SWRITE(bnext); SBAR();
        qkt(pB0, pB1, lds + bcur + SHM_V, qr, r32, hi);
        finishSM(pA0, pA1, alA, l_reg, pa0, pa1, pa2, pa3); SBAR();
        SLOAD((j + 2) * 64); SBAR();
        pv_d0(o, vb0 + bprev, pa0, pa1, pa2, pa3); partialSM(pB0, pB1, m_reg, mnB, alB);
        RESC(alB); __syncthreads();
        bprev = bcur; bcur = bnext; bnext = NEXTB(bnext);
        if (j + 2 < NT) SWRITE(bnext); SBAR();
        qkt(pA0, pA1, lds + bcur + SHM_V, qr, r32, hi);
        finishSM(pB0, pB1, alB, l_reg, pa0, pa1, pa2, pa3); SBAR();
        if (j + 3 < NT) SLOAD((j + 3) * 64); SBAR();
        pv_d0(o, vb0 + bprev, pa0, pa1, pa2, pa3); partialSM(pA0, pA1, m_reg, mnA, alA);
        RESC(alA); __syncthreads();
        bprev = bcur; bcur = bnext; bnext = NEXTB(bnext);
    }
    SBAR(); qkt(pB0, pB1, lds + bcur + SHM_V, qr, r32, hi);
    finishSM(pA0, pA1, alA, l_reg, pa0, pa1, pa2, pa3); SBAR();
    pv_d0(o, vb0 + bprev, pa0, pa1, pa2, pa3); partialSM(pB0, pB1, m_reg, mnB, alB);
    RESC(alB);
    finishSM(pB0, pB1, alB, l_reg, pa0, pa1, pa2, pa3); SBAR();
    pv_d0(o, vb0 + bcur, pa0, pa1, pa2, pa3);
    if (hi == 0) li_l[r32] = l_reg; asm volatile("s_waitcnt lgkmcnt(0)" ::: "memory");
    float rli[16];
#pragma unroll
    for (int r = 0; r < 16; ++r) rli[r] = __builtin_amdgcn_rcpf(li_l[crow(r, hi)]);
    bf16_t* Ow = Ob + (size_t)(wid * 32) * 1024;
#pragma unroll
    for (int r = 0; r < 16; ++r) { const int orow = crow(r, hi);
#pragma unroll
        for (int d0 = 0; d0 < 2; ++d0) Ow[(size_t)orow * 1024 + d0 * 32 + r32] = (ABL & 1) ? (bf16_t)0 : (bf16_t)f2bf(o[d0][r] * rli[r]); }
    __syncthreads();
#undef SLOAD
#undef SWRITE
#undef RESC
#undef NEXTB
}
__device__ __forceinline__ void unit64(const bf16_t* __restrict__ Qb, const bf16_t* __restrict__ Kh, const bf16_t* __restrict__ Vh, bf16_t* __restrict__ Ob, char* lds) {
    int tid = threadIdx.x; asm volatile("" : "+v"(tid));
    const int wid = __builtin_amdgcn_readfirstlane(tid >> 6), lane = tid & 63, r32 = lane & 31, hi = lane >> 5;
    constexpr int NT = NKEY / 64;
    const int vst = v_st(tid >> 3, (tid & 7) * 8);
    const int kc0 = tid, kc1 = 512 + tid; const bool k2 = tid < 256;
    const int kst0 = SHM_V + (kc0 / 12) * KROW + (kc0 % 12) * 16, kst1 = SHM_V + (kc1 / 12) * KROW + (kc1 % 12) * 16;
    struct { bf16x8 vs, ks0, ks1; } sr_;
#define SLOAD(k0) do { sr_.vs = *reinterpret_cast<const bf16x8*>(Vh + (size_t)(k0) * 64 + tid * 8); \
    sr_.ks0 = *reinterpret_cast<const bf16x8*>(Kh + (size_t)(k0) * 96 + kc0 * 8); \
    if (k2) sr_.ks1 = *reinterpret_cast<const bf16x8*>(Kh + (size_t)(k0) * 96 + kc1 * 8); } while (0)
#define SWRITE(bo) do { *(bf16x8*)(lds + (bo) + vst) = sr_.vs; *(bf16x8*)(lds + (bo) + kst0) = sr_.ks0; if (k2) *(bf16x8*)(lds + (bo) + kst1) = sr_.ks1; } while (0)
    float* ws = (float*)(lds + OFF_WS) + wid * 128;
    bf16x8 qr[2][6];
#pragma unroll
    for (int q = 0; q < 2; ++q) { const bf16_t* Qw = Qb + (size_t)(wid * 64 + q * 32 + r32) * 768 + hi * 8;
#pragma unroll
        for (int d0 = 0; d0 < 6; ++d0) qr[q][d0] = *reinterpret_cast<const bf16x8*>(Qw + d0 * 16); }
    float m_reg[2] = {-1e30f, -1e30f}, l_reg[2] = {0.f, 0.f}; f32x16 o[2][2] = {};
    const int vb0 = (int)(uintptr_t)lds + v_rd_base(lane);
    SLOAD(0); SWRITE(0); SLOAD(64);
    __syncthreads();
    int bc = 0, bn = BUFB;
    for (int j = 0; j < NT; ++j) {
        if (j + 1 < NT) SWRITE(bn);
        if (j + 2 < NT) SLOAD((j + 2) * 64);
        const char* Ks = lds + bc + SHM_V;
        f32x16 p[2][2] = {};
#pragma unroll
        for (int d0 = 0; d0 < 6; ++d0) { const int cb = (d0 * 16 + hi * 8) * 2;
            const bf16x8 b0 = *reinterpret_cast<const bf16x8*>(Ks + r32 * KROW + cb), b1 = *reinterpret_cast<const bf16x8*>(Ks + (32 + r32) * KROW + cb);
#pragma unroll
            for (int q = 0; q < 2; ++q) { p[q][0] = __builtin_amdgcn_mfma_f32_32x32x16_bf16(b0, qr[q][d0], p[q][0], 0, 0, 0); p[q][1] = __builtin_amdgcn_mfma_f32_32x32x16_bf16(b1, qr[q][d0], p[q][1], 0, 0, 0); } }
        bf16x8 pa[2][4];
#pragma unroll
        for (int q = 0; q < 2; ++q) { float mn, al; float* al_l = ws + q * 64;
            partialSM(p[q][0], p[q][1], m_reg[q], mn, al);
            if (__any(al < 1.f)) { if (hi == 0) al_l[r32] = al; asm volatile("s_waitcnt lgkmcnt(0)" ::: "memory");
#pragma unroll
                for (int d = 0; d < 2; ++d)
#pragma unroll
                    for (int r = 0; r < 16; ++r) o[q][d][r] *= al_l[crow(r, hi)]; }
            finishSM(p[q][0], p[q][1], al, l_reg[q], pa[q][0], pa[q][1], pa[q][2], pa[q][3]); }
        pv_joint<0>(o[0][0], o[1][0], vb0 + bc, pa); pv_joint<1>(o[0][1], o[1][1], vb0 + bc, pa);
        bc = bn; bn = (bn == 2 * BUFB) ? 0 : bn + BUFB;
        __syncthreads();
    }
#pragma unroll
    for (int q = 0; q < 2; ++q) { float* li_l = ws + q * 64 + 32;
        if (hi == 0) li_l[r32] = l_reg[q]; asm volatile("s_waitcnt lgkmcnt(0)" ::: "memory");
        bf16_t* Ow = Ob + (size_t)(wid * 64 + q * 32) * 1024;
#pragma unroll
        for (int r = 0; r < 16; ++r) { const int orow = crow(r, hi); const float rl = __builtin_amdgcn_rcpf(li_l[orow]);
#pragma unroll
            for (int d0 = 0; d0 < 2; ++d0) Ow[(size_t)orow * 1024 + d0 * 32 + r32] = (ABL & 1) ? (bf16_t)0 : (bf16_t)f2bf(o[q][d0][r] * rl); } }
    __syncthreads();
#undef SLOAD
#undef SWRITE
}
#undef SBAR
}
__device__ __forceinline__ void attn_phase(const Ctx& X) {
    const bf16_t* Q = (const bf16_t*)(X.ws + O_Q); const bf16_t* K = (const bf16_t*)(X.ws + O_K); const bf16_t* V = (const bf16_t*)(X.ws + O_V); bf16_t* Y = (bf16_t*)(X.ws + O_Y);
    for (int u = X.vcu; u < 64 * 8; u += X.G) { const int bh = u >> 3, qb = u & 7, b = bh >> 3, h = bh & 7;
        att::unit64(Q + (size_t)(b * 4096 + qb * 512) * 768 + h * 96, K + (size_t)bh * NKEY * 96, V + (size_t)bh * NKEY * 64, Y + (size_t)(b * 4096 + qb * 512) * 1024 + h * 64, (char*)X.lds); }
}


namespace lru {
constexpr int NCH = 80;
constexpr int WROW = 144;
constexpr int L_W = 0, L_CW = 4 * 64 * WROW;
constexpr int CW_CONV = 0, CW_CB = 256, CW_GB = 320, CW_SP = 576, CW_N = 704;
constexpr int L_WAVE = L_CW + 4096, WAVE_BYTES = 16 * WROW + 2 * 4096;
constexpr size_t O_LCNT = O_BAR + 16384;
constexpr size_t O_CARRY = 485 * MiB;
static_assert(O_CARRY >= O_Y + (size_t)TL * 1024 * 2 && O_CARRY + (size_t)16 * 80 * 512 * 4 <= WS_NEED, "carry map");
__device__ __forceinline__ void load_tables(const Ctx& X, int n) {
    LAS unsigned char* lds = X.lds; const bf16_t* WL = (const bf16_t*)(X.ws + O_WLRU); LAS float* cw = (LAS float*)(lds + L_CW);
    for (int i = X.tid; i < 4 * 512; i += 512) { const int mtx = i >> 9, r = (i >> 3) & 63, c8 = i & 7;
        *(LAS u32x4*)(lds + L_W + (mtx * 64 + r) * WROW + c8 * 16) = *(const u32x4*)(WL + ((size_t)(mtx * 8 + n) * 64 + r) * 64 + c8 * 8); }
    for (int i = X.tid; i < CW_N; i += 512) { float v;
        if (i < 256) v = X.in[12][(i >> 6) * 512 + n * 64 + (i & 63)];
        else if (i < 320) v = X.in[13][n * 64 + (i - 256)];
        else if (i < 576) { const int m = (i - 320) >> 6, c = (i - 320) & 63, d = m >> 1, g = m & 1; v = (g == 0 ? X.in[15] : X.in[17])[d * 512 + n * 64 + c]; }
        else { const int d = (i - 576) >> 6, c = (i - 576) & 63; v = ((const float*)(X.ws + O_SP))[d * 512 + n * 64 + c]; }
        cw[i] = v; }
    __syncthreads();
}
template <bool FINAL, int NSUB> __device__ __forceinline__ void task(const Ctx& X, int b, int n, int chunk) {
    const int lane = X.lane; LAS unsigned char* lds = X.lds; LAS unsigned char* wl = lds + L_WAVE + X.wave * WAVE_BYTES;
    LAS float* AT = (LAS float*)(wl + 16 * WROW); LAS float* BT = AT + 1024; const LAS float* cw = (const LAS float*)(lds + L_CW);
    const bf16_t* PX = (const bf16_t*)(X.ws + O_PX);
    const bool isctx = chunk < 16; const int segbase = isctx ? TL + b * 256 : b * 4096, seglen = isctx ? 256 : 4096, pos0 = isctx ? chunk * 16 : (chunk - 16) * 64;
    const int pa = lane & 15, kq = lane >> 4;
    float carry[2] = {0.f, 0.f};
    if constexpr (FINAL) { carry[0] = ((const float*)(X.ws + O_CARRY))[((size_t)(b * 2 + 0) * NCH + chunk) * 512 + n * 64 + lane]; carry[1] = ((const float*)(X.ws + O_CARRY))[((size_t)(b * 2 + 1) * NCH + chunk) * 512 + n * 64 + lane]; }
#define LRU_LOADPX(ss_, dst) do { const int p0_ = pos0 + (ss_) * 16; \
        _Pragma("unroll") for (int ks = 0; ks < 2; ++ks) _Pragma("unroll") for (int j = 0; j < 4; ++j) { const int p = p0_ + pa - 2 + j; \
            dst[ks][j] = (p >= 0 && p < seglen) ? *(const u32x4*)(PX + (size_t)(segbase + p) * 512 + n * 64 + 32 * ks + 8 * kq) : (u32x4){0u, 0u, 0u, 0u}; } } while (0)
    unsigned abp[NSUB][16];
    float h = carry[0], Atot = 1.f;
#pragma unroll
    for (int ss = 0; ss < NSUB; ++ss) { const int p0 = pos0 + ss * 16;
        u32x4 px[2][4];
        LRU_LOADPX(ss, px);
        bf16x8 af[2];
#pragma unroll
        for (int ks = 0; ks < 2; ++ks) { const int c0 = 32 * ks + 8 * kq; float u[8];
            { const f32x4 b0 = *(const LAS f32x4*)(cw + CW_CB + c0), b1 = *(const LAS f32x4*)(cw + CW_CB + c0 + 4); u[0] = b0.x; u[1] = b0.y; u[2] = b0.z; u[3] = b0.w; u[4] = b1.x; u[5] = b1.y; u[6] = b1.z; u[7] = b1.w; }
#pragma unroll
            for (int j = 0; j < 4; ++j) { const u32x4 w = px[ks][j];
                const f32x4 w0 = *(const LAS f32x4*)(cw + CW_CONV + j * 64 + c0), w1 = *(const LAS f32x4*)(cw + CW_CONV + j * 64 + c0 + 4);
                u[0] += bf2f(w.x & 0xffff) * w0.x; u[1] += bf2f(w.x >> 16) * w0.y; u[2] += bf2f(w.y & 0xffff) * w0.z; u[3] += bf2f(w.y >> 16) * w0.w;
                u[4] += bf2f(w.z & 0xffff) * w1.x; u[5] += bf2f(w.z >> 16) * w1.y; u[6] += bf2f(w.w & 0xffff) * w1.z; u[7] += bf2f(w.w >> 16) * w1.w; }
            u32x4 o; o.x = pk2(u[0], u[1]); o.y = pk2(u[2], u[3]); o.z = pk2(u[4], u[5]); o.w = pk2(u[6], u[7]);
            af[ks] = __builtin_bit_cast(bf16x8, o);
            *(LAS u32x4*)(wl + pa * WROW + c0 * 2) = o; }
#pragma unroll
        for (int t = 0; t < 4; ++t) { f32x4 z[4];
#pragma unroll
            for (int mtx = 0; mtx < 4; ++mtx) { z[mtx] = (f32x4){0.f, 0.f, 0.f, 0.f};
#pragma unroll
                for (int ks = 0; ks < 2; ++ks) { const bf16x8 bw = *(const LAS bf16x8*)(lds + L_W + (mtx * 64 + t * 16 + pa) * WROW + (ks * 32 + kq * 8) * 2);
                    z[mtx] = __builtin_amdgcn_mfma_f32_16x16x32_bf16(af[ks], bw, z[mtx], 0, 0, 0); } }
            const int ch = t * 16 + pa; float gba[2], gbx[2], sp8[2];
#pragma unroll
            for (int d = 0; d < 2; ++d) { gba[d] = cw[CW_GB + (d * 2) * 64 + ch]; gbx[d] = cw[CW_GB + (d * 2 + 1) * 64 + ch]; sp8[d] = -8.f * cw[CW_SP + d * 64 + ch]; }
#pragma unroll
            for (int r = 0; r < 4; ++r) { const int pos = 4 * kq + r;
                const float uu = bf2f(*(const LAS unsigned short*)(wl + pos * WROW + ch * 2));
#pragma unroll
                for (int d = 0; d < 2; ++d) {
                    const float rg = __builtin_amdgcn_rcpf(1.f + __builtin_amdgcn_exp2f(-1.4426950408889634f * (z[d * 2][r] + gba[d])));
                    const float ig = __builtin_amdgcn_rcpf(1.f + __builtin_amdgcn_exp2f(-1.4426950408889634f * (z[d * 2 + 1][r] + gbx[d])));
                    const float la = sp8[d] * rg;
                    const float e1 = la * (1.f + la * (0.5f + la * (0.16666667f + la * (0.041666668f + la * 0.0083333338f))));
                    const float m2 = -e1 * (2.f + e1);
                    const float av = 1.f + e1, bv = __builtin_amdgcn_sqrtf(m2) * (ig * uu);
                    if (d == 0) { AT[pos * 64 + ch] = av; BT[pos * 64 + ch] = bv; } else abp[ss][t * 4 + r] = pk2(e1, bv); } } }
        float hs[16];
#pragma unroll
        for (int q = 0; q < 16; ++q) { const float a = AT[q * 64 + lane], bv = BT[q * 64 + lane]; h = a * h + bv; Atot *= a; hs[q] = h; }
        if constexpr (FINAL) { bf16_t* Y = (bf16_t*)(X.ws + O_Y) + ((size_t)b * 4096 + p0) * 1024 + 512 + n * 64 + lane;
#pragma unroll
            for (int q = 0; q < 16; ++q) Y[(size_t)q * 1024] = (bf16_t)f2bf(hs[q]); }
        asm volatile("" ::: "memory");
    }
    if constexpr (!FINAL) *(f32x2*)((float*)(X.ws + O_AGG) + (((size_t)(b * 2 + 0) * NCH + chunk) * 512 + n * 64 + lane) * 2) = (f32x2){Atot, h};
    h = carry[1]; Atot = 1.f;
#pragma unroll
    for (int s2 = 0; s2 < NSUB; ++s2) { const int ss = NSUB - 1 - s2, p0 = pos0 + ss * 16;
        unsigned short yraw[16], graw[16];
        if constexpr (FINAL) { const bf16_t* Yr = (const bf16_t*)(X.ws + O_Y) + ((size_t)b * 4096 + p0) * 1024 + 512 + n * 64 + lane; const bf16_t* GG = (const bf16_t*)(X.ws + O_GG) + ((size_t)b * 4096 + p0) * 512 + n * 64 + lane;
#pragma unroll
            for (int q = 0; q < 16; ++q) { yraw[q] = Yr[(size_t)(15 - q) * 1024]; graw[q] = GG[(size_t)(15 - q) * 512]; } }
#pragma unroll
        for (int t = 0; t < 4; ++t)
#pragma unroll
            for (int r = 0; r < 4; ++r) { const int pos = 4 * kq + r, ch = t * 16 + pa; const unsigned w = abp[ss][t * 4 + r]; AT[pos * 64 + ch] = 1.f + bf2f((unsigned short)(w & 0xffffu)); BT[pos * 64 + ch] = bf2f((unsigned short)(w >> 16)); }
        float hs[16];
#pragma unroll
        for (int q = 0; q < 16; ++q) { const int pos = 15 - q; const float a = AT[pos * 64 + lane], bv = BT[pos * 64 + lane]; h = a * h + bv; Atot *= a; hs[q] = h; }
        if constexpr (FINAL) { bf16_t* Y = (bf16_t*)(X.ws + O_Y) + ((size_t)b * 4096 + p0) * 1024 + 512 + n * 64 + lane;
#pragma unroll
            for (int q = 0; q < 16; ++q) { const float yv = (bf2f(yraw[q]) + hs[q]) * bf2f(graw[q]); Y[(size_t)(15 - q) * 1024] = (ABL & 2) ? (bf16_t)0 : (bf16_t)f2bf(yv); } }
        asm volatile("" ::: "memory");
    }
    if constexpr (!FINAL) *(f32x2*)((float*)(X.ws + O_AGG) + (((size_t)(b * 2 + 1) * NCH + chunk) * 512 + n * 64 + lane) * 2) = (f32x2){Atot, h};
#undef LRU_LOADPX
}
}
__device__ __forceinline__ void lru_a_phase(const Ctx& X0) { const Ctx X = fresh(X0);
    const int n = X.vcu & 7, ngrp = X.G >> 3, wq = (X.vcu >> 3) * 8 + X.wave, nwq = ngrp * 8;
    lru::load_tables(X, n);
    for (int t = wq; t < 512; t += nwq) lru::task<false, 4>(X, t >> 6, n, 16 + (t & 63));
    for (int t = wq; t < 128; t += nwq) lru::task<false, 1>(X, t >> 4, n, t & 15);
    asm volatile("s_waitcnt vmcnt(0)" ::: "memory"); __syncthreads();
    LAS unsigned* flag = (LAS unsigned*)(X.lds + lru::L_CW + lru::CW_N * 4);
    if (X.tid == 0) { __builtin_amdgcn_fence(__ATOMIC_RELEASE, "agent"); asm volatile("s_waitcnt vmcnt(0)" ::: "memory");
        const unsigned old = __hip_atomic_fetch_add((unsigned*)(X.ws + lru::O_LCNT) + n * 64, 1u, __ATOMIC_RELAXED, __HIP_MEMORY_SCOPE_AGENT);
        const unsigned last = (old == (unsigned)(ngrp - 1)) ? 1u : 0u; if (last) { __builtin_amdgcn_fence(__ATOMIC_ACQUIRE, "agent"); asm volatile("s_waitcnt vmcnt(0)" ::: "memory"); } *flag = last; }
    __syncthreads();
    if (*flag) { const float* AGG = (const float*)(X.ws + O_AGG); float* CAR = (float*)(X.ws + lru::O_CARRY);
        for (int bd = X.wave; bd < 16; bd += 8) { const int d = bd & 1; const size_t base = (size_t)bd * lru::NCH * 512 + n * 64 + X.lane; float h = 0.f;
#pragma unroll 1
            for (int j0 = 0; j0 < lru::NCH; j0 += 20) { f32x2 v[20];
#pragma unroll
                for (int j = 0; j < 20; ++j) { const int jj = j0 + j, cj = d == 0 ? jj : (jj < 16 ? 15 - jj : 79 - (jj - 16)); v[j] = __builtin_nontemporal_load((const f32x2*)(AGG + (base + (size_t)cj * 512) * 2)); }
#pragma unroll
                for (int j = 0; j < 20; ++j) { const int jj = j0 + j, cj = d == 0 ? jj : (jj < 16 ? 15 - jj : 79 - (jj - 16)); CAR[base + (size_t)cj * 512] = h; h = v[j].x * h + v[j].y; } } } }
    __syncthreads();
}
__device__ __forceinline__ void lru_c_phase(const Ctx& X0) { const Ctx X = fresh(X0);
    const int n = X.vcu & 7, ngrp = X.G >> 3, wq = (X.vcu >> 3) * 8 + X.wave, nwq = ngrp * 8;
    lru::load_tables(X, n);
    for (int t = wq; t < 512; t += nwq) lru::task<true, 4>(X, t >> 6, n, 16 + (t & 63));
    __syncthreads();
}


__device__ __forceinline__ void m0_phase(const Ctx& X0, int rep_ = 0) { const Ctx X = fresh(X0);
    LAS unsigned char* lds = X.lds; LAS float* ft = (LAS float*)lds;
    constexpr int FS = 1028;
    LAS float* SEL = (LAS float*)(lds + 32 * FS * 4);
    LAS float* SCO = SEL + 32 * 65;
    LAS unsigned* EB = (LAS unsigned*)(SCO + 32 * 65);
    const float* mod = (const float*)(X.ws + O_MOD); const float* gf = X.in[20]; const float* wrt = (const float*)(X.ws + O_WRT); const float* rb = X.in[22];
    int* RTE = (int*)(X.ws + O_RTE); float* RTW = (float*)(X.ws + O_RTW); int* HIST = (int*)(X.ws + O_HIST); int* RANK = (int*)(X.ws + O_RANK);
    const int tid = X.tid, lane = X.lane, wave = X.wave;
    for (int i = X.bid * 512 + tid; i < 2 * RSLOTS; i += X.G * 512) ((int*)(X.ws + O_SLOT))[i] = -1;
    const bf16_t* wrh = (const bf16_t*)(X.ws + O_WRT);
    f32x4 v[4][4];
#define M0_LOADROWS(it_) do { _Pragma("unroll") for (int rr = 0; rr < 4; ++rr) { const f32x4* xr = (const f32x4*)(X.out + (size_t)((it_) * 32 + wave * 4 + rr) * D_) + lane; \
        _Pragma("unroll") for (int j = 0; j < 4; ++j) v[rr][j] = xr[64 * j]; } } while (0)
    if (X.bid < 1024) M0_LOADROWS(X.bid);
    for (int it = X.bid; it < 1024; it += X.G) {
        const int tok0 = it * 32;
        { float ss[4];
#pragma unroll
            for (int rr = 0; rr < 4; ++rr) { float s = 0.f;
#pragma unroll
                for (int j = 0; j < 4; ++j) s += (v[rr][j].x * v[rr][j].x + v[rr][j].y * v[rr][j].y) + (v[rr][j].z * v[rr][j].z + v[rr][j].w * v[rr][j].w);
                ss[rr] = s; }
#pragma unroll
            for (int o = 1; o < 64; o <<= 1) {
#pragma unroll
                for (int rr = 0; rr < 4; ++rr) ss[rr] += __shfl_xor(ss[rr], o); }
            const float* md = mod + (size_t)(tok0 >> 12) * 6144; float rstd[4];
#pragma unroll
            for (int rr = 0; rr < 4; ++rr) rstd[rr] = 1.f / sqrtf(ss[rr] * (1.f / D_) + EPS);
            const bool h0 = tok0 < HALF_T; bf16_t* Fb = h0 ? (bf16_t*)(X.ws + O_YS) + (size_t)(tok0 + wave * 4) * D_ : (bf16_t*)(X.ws + O_F1) + (size_t)(tok0 + wave * 4 - HALF_T) * D_;
#pragma unroll
            for (int j = 0; j < 4; ++j) { const f32x4 gg = ((const f32x4*)gf)[lane + 64 * j], sh = ((const f32x4*)(md + 3072))[lane + 64 * j], sc = ((const f32x4*)(md + 4096))[lane + 64 * j]; const f32x4 gs = gg * (sc + 1.f);
#pragma unroll
                for (int rr = 0; rr < 4; ++rr) { const f32x4 h = v[rr][j] * rstd[rr] * gs + sh; u32x2 w; w.x = pk2(h.x, h.y); w.y = pk2(h.z, h.w); ((u32x2*)(Fb + (size_t)rr * D_))[lane + 64 * j] = w;
                    *(LAS f32x4*)(ft + (wave * 4 + rr) * FS + 4 * lane + 256 * j) = h; } } }
        __syncthreads();
        if (it + X.G < 1024) M0_LOADROWS(it + X.G);
        f32x16 a0 = {}, a1 = {};
        { const int i = lane & 31, kh = lane >> 5; const LAS float* fa = ft + i * FS + wave * 128 + 8 * kh; const bf16_t* wb = wrh + (size_t)i * 1024 + wave * 128 + 8 * kh;
            bf16x8 bh0[8], bl0[8], bh1[8], bl1[8];
#pragma unroll
            for (int s = 0; s < 8; ++s) { bh0[s] = *(const bf16x8*)(wb + 16 * s); bh1[s] = *(const bf16x8*)(wb + 32 * 1024 + 16 * s); bl0[s] = *(const bf16x8*)(wb + 64 * 1024 + 16 * s); bl1[s] = *(const bf16x8*)(wb + 96 * 1024 + 16 * s); }
#pragma unroll
            for (int s = 0; s < 8; ++s) { const f32x4 x0 = *(const LAS f32x4*)(fa + 16 * s), x1 = *(const LAS f32x4*)(fa + 16 * s + 4); const float xs[8] = {x0.x, x0.y, x0.z, x0.w, x1.x, x1.y, x1.z, x1.w};
                unsigned hw[4], lw[4];
#pragma unroll
                for (int q = 0; q < 4; ++q) { const unsigned h = pk2(xs[2 * q], xs[2 * q + 1]); hw[q] = h; lw[q] = pk2(xs[2 * q] - bf2f((unsigned short)(h & 0xffffu)), xs[2 * q + 1] - bf2f((unsigned short)(h >> 16))); }
                const u32x4 hv = {hw[0], hw[1], hw[2], hw[3]}, lv = {lw[0], lw[1], lw[2], lw[3]}; const bf16x8 ah = __builtin_bit_cast(bf16x8, hv), al = __builtin_bit_cast(bf16x8, lv);
                a0 = __builtin_amdgcn_mfma_f32_32x32x16_bf16(ah, bh0[s], a0, 0, 0, 0); a1 = __builtin_amdgcn_mfma_f32_32x32x16_bf16(ah, bh1[s], a1, 0, 0, 0);
                a0 = __builtin_amdgcn_mfma_f32_32x32x16_bf16(ah, bl0[s], a0, 0, 0, 0); a1 = __builtin_amdgcn_mfma_f32_32x32x16_bf16(ah, bl1[s], a1, 0, 0, 0);
                a0 = __builtin_amdgcn_mfma_f32_32x32x16_bf16(al, bh0[s], a0, 0, 0, 0); a1 = __builtin_amdgcn_mfma_f32_32x32x16_bf16(al, bh1[s], a1, 0, 0, 0); } }
        __syncthreads();
        { LAS float* pw = ft + wave * 2048; const int col = lane & 31, hi = lane >> 5;
#pragma unroll
            for (int r = 0; r < 16; ++r) { const int row = (r & 3) + 8 * (r >> 2) + 4 * hi; pw[row * 64 + col] = a0[r]; pw[row * 64 + 32 + col] = a1[r]; } }
        if (tid < 64) EB[tid] = 0u;
        __syncthreads();
        { const int tk = tid >> 4, e4 = (tid & 15) * 4; f32x4 lg = {0.f, 0.f, 0.f, 0.f};
#pragma unroll
            for (int w = 0; w < 8; ++w) lg += *(const LAS f32x4*)(ft + w * 2048 + tk * 64 + e4);
            const f32x4 bv = *(const f32x4*)(rb + e4);
#pragma unroll
            for (int e = 0; e < 4; ++e) { const float sc = 1.f / (1.f + expf(-lg[e])); SCO[tk * 65 + e4 + e] = sc; SEL[tk * 65 + e4 + e] = sc + bv[e]; } }
        __syncthreads();
        if (tid < 32) { const int tok = tok0 + tid; float sv[64];
#pragma unroll
            for (int j = 0; j < 64; ++j) sv[j] = SEL[tid * 65 + j];
            float gsc[8];
#pragma unroll
            for (int g = 0; g < 8; ++g) { float m1 = -INFINITY, m2 = -INFINITY;
#pragma unroll
                for (int j = 0; j < 8; ++j) { const float x = sv[g * 8 + j]; const bool gt = x > m1; m2 = gt ? m1 : fmaxf(m2, x); m1 = gt ? x : m1; }
                gsc[g] = m1 + m2; }
#pragma unroll
            for (int g = 0; g < 8; ++g) { int rk = 0;
#pragma unroll
                for (int g2 = 0; g2 < 8; ++g2) if (g2 != g) rk += (gsc[g2] > gsc[g] || (gsc[g2] == gsc[g] && g2 < g)) ? 1 : 0;
                if (rk >= 4) {
#pragma unroll
                    for (int j = 0; j < 8; ++j) sv[g * 8 + j] = -INFINITY; } }
            int ek[8]; float sk[8]; float ssum = 0.f;
#pragma unroll
            for (int k = 0; k < 8; ++k) { float best = -INFINITY; int bi = 0;
#pragma unroll
                for (int j = 0; j < 64; ++j) { const bool gt = sv[j] > best; best = gt ? sv[j] : best; bi = gt ? j : bi; }
#pragma unroll
                for (int j = 0; j < 64; ++j) sv[j] = (j == bi) ? -INFINITY : sv[j];
                ek[k] = bi; sk[k] = SCO[tid * 65 + bi]; ssum += sk[k]; }
            const float inv = 2.5f / ssum;
#pragma unroll
            for (int k = 0; k < 8; ++k) (void)__hip_atomic_fetch_or(EB + ek[k], 1u << tid, __ATOMIC_RELAXED, __HIP_MEMORY_SCOPE_WORKGROUP);
            asm volatile("s_waitcnt lgkmcnt(0)" ::: "memory");
            int4 e0 = {ek[0], ek[1], ek[2], ek[3]}, e1 = {ek[4], ek[5], ek[6], ek[7]}; *(int4*)(RTE + (size_t)tok * 8) = e0; *(int4*)(RTE + (size_t)tok * 8 + 4) = e1;
            *(f32x4*)(RTW + (size_t)tok * 8) = (f32x4){sk[0] * inv, sk[1] * inv, sk[2] * inv, sk[3] * inv}; *(f32x4*)(RTW + (size_t)tok * 8 + 4) = (f32x4){sk[4] * inv, sk[5] * inv, sk[6] * inv, sk[7] * inv};
            const unsigned below = (1u << tid) - 1u; int rk[8];
#pragma unroll
            for (int k = 0; k < 8; ++k) rk[k] = __popc(EB[ek[k]] & below);
            int4 r0 = {rk[0], rk[1], rk[2], rk[3]}, r1 = {rk[4], rk[5], rk[6], rk[7]}; *(int4*)(RANK + (size_t)tok * 8) = r0; *(int4*)(RANK + (size_t)tok * 8 + 4) = r1; }
        if (tid < 64) { asm volatile("s_waitcnt lgkmcnt(0)" ::: "memory"); HIST[it * 64 + tid] = __popc(EB[tid]); }
    }
    __syncthreads();
#undef M0_LOADROWS
}
__device__ __forceinline__ void m2_phase(const Ctx& X0) { const Ctx X = fresh(X0);
    LAS int* part = (LAS int*)X.lds;
    LAS int* offb = part + 1024;
    const int* HIST = (const int*)(X.ws + O_HIST); const int* RTE = (const int*)(X.ws + O_RTE); const int* RANK = (const int*)(X.ws + O_RANK);
    int* SLOT = (int*)(X.ws + O_SLOT); int* CNT = (int*)(X.ws + O_CNT);
    const int tid = X.tid, lane = X.lane, wave = X.wave;
    for (int it = X.bid; it < 1024; it += X.G) { const int half = it >> 9, li = it & 511;
        { int slt = 0, sall = 0; const int* hp = HIST + (size_t)(half * 512 + wave * 64) * 64 + lane;
#pragma unroll 8
            for (int r = 0; r < 64; ++r) { const int v = hp[r * 64]; sall += v; slt += (wave * 64 + r < li) ? v : 0; }
            part[(wave * 64 + lane) * 2] = slt; part[(wave * 64 + lane) * 2 + 1] = sall; }
        __syncthreads();
        if (wave == 0) { int off = 0, cnt = 0;
#pragma unroll
            for (int w = 0; w < 8; ++w) { off += part[(w * 64 + lane) * 2]; cnt += part[(w * 64 + lane) * 2 + 1]; }
            const int tiles = (cnt + 255) >> 8; int incl = tiles;
#pragma unroll
            for (int o = 1; o < 64; o <<= 1) { const int v = __shfl_up(incl, o); if (lane >= o) incl += v; }
            const int tbase = incl - tiles;
            offb[lane] = tbase * 256 + off;
            if (li == 0) { for (int t = 0; t < tiles; ++t) CNT[64 + half * 704 + tbase + t] = lane; if (lane == 63) CNT[half] = incl; } }
        __syncthreads();
        if (tid < 256) { const int tok = it * 32 + (tid >> 3), k = tid & 7; const int e = RTE[(size_t)tok * 8 + k];
            SLOT[(size_t)half * RSLOTS + offb[e] + RANK[(size_t)tok * 8 + k]] = (tok - half * HALF_T) * 8 + k; }
        __syncthreads();
    }
}
__device__ __forceinline__ void combine_phase(const Ctx& X0, int half, int nostore = 0) { const Ctx X = fresh(X0);
    const int gw = X.bid * 8 + X.wave, NGW = X.G * 8; const float* fg = X.in[29]; const float* mod = (const float*)(X.ws + O_MOD);
    const unsigned char* YS = X.ws + O_YS; const float* RTW = (const float*)(X.ws + O_RTW);
    for (int lt = gw; lt < HALF_T; lt += NGW) { const int tok = half * HALF_T + lt; const float* g2 = mod + (size_t)(tok >> 12) * 6144 + 5120 + 16 * X.lane;
        f32x4* op = (f32x4*)(X.out + (size_t)tok * D_ + 16 * X.lane); f32x4 r[4] = {}; u32x4 y[8]; f32x4 wv0 = *(const f32x4*)(RTW + (size_t)tok * 8), wv1 = *(const f32x4*)(RTW + (size_t)tok * 8 + 4);
#pragma unroll
        for (int k = 0; k < 8; ++k) y[k] = *(const u32x4*)(YS + (size_t)(lt * 8 + k) * D_ + 16 * X.lane);
        f32x4 xv[4];
#pragma unroll
        for (int j = 0; j < 4; ++j) xv[j] = op[j];
        { const u32x4 s0 = *(const u32x4*)((const bf16_t*)(X.ws + O_YSH) + (size_t)lt * D_ + 16 * X.lane), s1 = *(const u32x4*)((const bf16_t*)(X.ws + O_YSH) + (size_t)lt * D_ + 16 * X.lane + 8);
            r[0] = (f32x4){bf2f(s0.x & 0xffff), bf2f(s0.x >> 16), bf2f(s0.y & 0xffff), bf2f(s0.y >> 16)}; r[1] = (f32x4){bf2f(s0.z & 0xffff), bf2f(s0.z >> 16), bf2f(s0.w & 0xffff), bf2f(s0.w >> 16)};
            r[2] = (f32x4){bf2f(s1.x & 0xffff), bf2f(s1.x >> 16), bf2f(s1.y & 0xffff), bf2f(s1.y >> 16)}; r[3] = (f32x4){bf2f(s1.z & 0xffff), bf2f(s1.z >> 16), bf2f(s1.w & 0xffff), bf2f(s1.w >> 16)}; }
#pragma unroll
        for (int k = 0; k < 8; ++k) { const float w = (ABL & 4) ? 0.f : (k < 4 ? wv0[k & 3] : wv1[k & 3]) * (1.f / YSCALE); const unsigned yw[4] = {y[k].x, y[k].y, y[k].z, y[k].w};
#pragma unroll
            for (int j = 0; j < 4; ++j) { const f32x2 lo = __builtin_amdgcn_cvt_pk_f32_fp8((int)yw[j], false), hi = __builtin_amdgcn_cvt_pk_f32_fp8((int)yw[j], true);
                r[j].x += w * lo.x; r[j].y += w * lo.y; r[j].z += w * hi.x; r[j].w += w * hi.y; } }
        f32x4 v[4]; float s = 0.f;
#pragma unroll
        for (int j = 0; j < 4; ++j) { v[j] = xv[j] + ((const f32x4*)g2)[j] * r[j]; s += (v[j].x * v[j].x + v[j].y * v[j].y) + (v[j].z * v[j].z + v[j].w * v[j].w); }
        const float rstd = 1.f / sqrtf(wave_sum(s) * (1.f / D_) + EPS);
#pragma unroll
        for (int j = 0; j < 4; ++j) { const f32x4 o = v[j] * rstd * ((const f32x4*)(fg + 16 * X.lane))[j]; if (!nostore) op[j] = o; else if (o.x == 12345.678f) op[j] = o; }
    }
}
__device__ __forceinline__ void moe_dst_preload(const Ctx& X0, const MoeOrder& S, LAS int* tab) { const Ctx X = fresh(X0);
    const int* SLOT = (const int*)(X.ws + O_SLOT) + (size_t)S.half * RSLOTS; pg8::Unit u;
    for (int i = 0; S.next(i, u); ++i) { if (X.tid < 256) tab[i * 256 + X.tid] = u.pm < RTILES ? SLOT[(size_t)u.pm * 256 + X.tid] : 0; }
    __syncthreads();
}
__device__ __forceinline__ void moe_rows_preload(const Ctx& X0, const MoeOrder& S, LAS int* tab) { const Ctx X = fresh(X0);
    const int* SLOT = (const int*)(X.ws + O_SLOT) + (size_t)S.half * RSLOTS; pg8::Unit u;
    for (int i = 0; S.next(i, u); ++i) { if (X.tid < 256) { int v; if (u.pm < RTILES) { const int d = SLOT[(size_t)u.pm * 256 + X.tid]; v = d < 0 ? 0 : (d >> 3); } else v = (u.pm - RTILES) * 256 + X.tid; tab[i * 256 + X.tid] = v; } }
    __syncthreads();
}

__device__ __forceinline__ void final_norm_rows(const Ctx& X0, const float* src) { const Ctx X = fresh(X0);
    const int gw = X.bid * 8 + X.wave, NGW = X.G * 8; const float* fg = X.in[29];
    for (int m = gw; m < TL; m += NGW) {
        const f32x4* xr = (const f32x4*)(src + (size_t)m * D_) + X.lane; f32x4 v[4]; float s = 0.f;
#pragma unroll
        for (int j = 0; j < 4; ++j) { v[j] = xr[64 * j]; s += (v[j].x * v[j].x + v[j].y * v[j].y) + (v[j].z * v[j].z + v[j].w * v[j].w); }
        const float rstd = 1.f / sqrtf(wave_sum(s) * (1.f / D_) + EPS);
        f32x4* o = (f32x4*)(X.out + (size_t)m * D_) + X.lane;
#pragma unroll
        for (int j = 0; j < 4; ++j) { const f32x4 g = ((const f32x4*)fg)[X.lane + 64 * j]; o[64 * j] = v[j] * rstd * g; }
    }
}


#ifdef DIAG
constexpr size_t O_FLAG = 10 * MiB + 768 * 1024;
constexpr size_t O_HCHK = 490 * MiB;
__device__ __forceinline__ void flag_fail(unsigned char* ws, int k) { atomicAdd((unsigned*)(ws + O_FLAG) + k, 1u); }
__device__ __forceinline__ bool badcmp(float got, float want, float tol) { return !(fabsf(got - want) <= tol * (1.f + fabsf(want))); }
__device__ void chk_p(const Ctx& X) {
    const int rows[8] = {0, 257, 4099, 20000, 32767, 32768, 33000, 34815};
    const float* mod = (const float*)(X.ws + O_MOD);
    for (int it = X.bid * 512 + X.tid; it < 8 * 1440; it += X.G * 512) { const int ri = it / 1440, col = it % 1440;
        int m = 0;
#pragma unroll
        for (int q = 0; q < 8; ++q) if (q == ri) m = rows[q];
        const float* src = m < TL ? X.in[0] + (size_t)m * D_ : X.in[2] + (size_t)(m - TL) * D_; const float* md = mod + (size_t)(m < TL ? (m >> 12) : 8) * 6144;
        float ss = 0.f; for (int k = 0; k < 1024; ++k) ss += src[k] * src[k];
        const float rstd = 1.f / sqrtf(ss / 1024.f + EPS); float acc = 0.f;
        for (int k = 0; k < 1024; ++k) { const float h = src[k] * rstd * X.in[6][k] * (1.f + md[1024 + k]) + md[k]; acc += h * X.in[7][(size_t)k * 1440 + col]; }
        float got;
        if (col < 256) got = bf2f(((const bf16_t*)(X.ws + O_PQ))[(size_t)m * 256 + col]);
        else if (col < 384) got = bf2f(((const bf16_t*)(X.ws + O_PKV))[(size_t)m * 256 + col - 256]);
        else if (col < 416) got = bf2f(((const bf16_t*)(X.ws + O_PKV))[(size_t)m * 256 + 128 + rope_int(col - 384)]);
        else if (col < 928) got = bf2f(((const bf16_t*)(X.ws + O_PX))[(size_t)m * 512 + col - 416]);
        else { if (m >= TL) continue; got = bf2f(((const bf16_t*)(X.ws + O_GG))[(size_t)m * 512 + col - 928]); acc = gelu_tanh(acc); }
        if (badcmp(got, acc, 0.03f)) flag_fail(X.ws, 0);
    }
}
constexpr int NLS = 8;
__device__ void chk_lru_scan(const Ctx& X) {
    const int sb[NLS] = {0, 0, 3, 7, 5, 2, 6, 1}, sn[NLS] = {0, 7, 3, 5, 0, 1, 6, 4}, sc[NLS] = {0, 63, 17, 40, 33, 5, 60, 21};
    if (X.tid >= 64 || X.bid >= NLS * 2) return;
    const int si = X.bid >> 1, d = X.bid & 1, c = X.tid; int b = 0, n = 0, cd = 0;
#pragma unroll
    for (int q = 0; q < NLS; ++q) if (q == si) { b = sb[q]; n = sn[q]; cd = sc[q]; }
    const bf16_t* PX = (const bf16_t*)(X.ws + O_PX); float* H = (float*)(X.ws + O_HCHK) + (size_t)(si * 2 + d) * 4096;
    const float wa = X.in[14][(size_t)(d * 8 + n) * 4096 + c * 64 + cd], wx = X.in[16][(size_t)(d * 8 + n) * 4096 + c * 64 + cd];
    const float ba = X.in[15][d * 512 + n * 64 + cd], bx = X.in[17][d * 512 + n * 64 + cd], lam = X.in[18][d * 512 + n * 64 + cd];
    const float cb = X.in[13][n * 64 + c], cw0 = X.in[12][0 * 512 + n * 64 + c], cw1 = X.in[12][1 * 512 + n * 64 + c], cw2 = X.in[12][2 * 512 + n * 64 + c], cw3 = X.in[12][3 * 512 + n * 64 + c];
    const float sp = log1pf(expf(-lam)); float h = 0.f;
    for (int step = 0; step < NKEY; ++step) {
        const bool isctx = step < 256; const int p = isctx ? (d == 0 ? step : 255 - step) : (d == 0 ? step - 256 : 4095 - (step - 256));
        const int segbase = isctx ? TL + b * 256 : b * 4096, seglen = isctx ? 256 : 4096;
        float u = cb;
        if (p - 2 >= 0) u += bf2f(PX[(size_t)(segbase + p - 2) * 512 + n * 64 + c]) * cw0;
        if (p - 1 >= 0) u += bf2f(PX[(size_t)(segbase + p - 1) * 512 + n * 64 + c]) * cw1;
        u += bf2f(PX[(size_t)(segbase + p) * 512 + n * 64 + c]) * cw2;
        if (p + 1 < seglen) u += bf2f(PX[(size_t)(segbase + p + 1) * 512 + n * 64 + c]) * cw3;
        const float za = ba + wave_sum(u * wa), zx = bx + wave_sum(u * wx), ud = __shfl(u, cd);
        const float r = 1.f / (1.f + expf(-za)), ig = 1.f / (1.f + expf(-zx)); const float la = -8.f * r * sp; const float a = expf(la), bb = sqrtf(-expm1f(2.f * la)) * (ig * ud);
        h = a * h + bb; if (!isctx && c == 0) H[p] = h;
    }
}
__device__ void chk_lru_cmp(const Ctx& X) {
    const int sb[NLS] = {0, 0, 3, 7, 5, 2, 6, 1}, sn[NLS] = {0, 7, 3, 5, 0, 1, 6, 4}, sc[NLS] = {0, 63, 17, 40, 33, 5, 60, 21};
    for (int it = X.bid * 512 + X.tid; it < NLS * 4096; it += X.G * 512) { const int si = it >> 12, p = it & 4095; int b = 0, n = 0, cd = 0;
#pragma unroll
        for (int q = 0; q < NLS; ++q) if (q == si) { b = sb[q]; n = sn[q]; cd = sc[q]; }
        const float* H = (const float*)(X.ws + O_HCHK) + (size_t)(si * 2) * 4096; const size_t row = (size_t)b * 4096 + p;
        const float want = (H[p] + H[4096 + p]) * bf2f(((const bf16_t*)(X.ws + O_GG))[row * 512 + n * 64 + cd]);
        const float got = bf2f(((const bf16_t*)(X.ws + O_Y))[row * 1024 + 512 + n * 64 + cd]);
        if (badcmp(got, want, 0.03f)) flag_fail(X.ws, 1);
    }
}
__device__ void chk_x1(const Ctx& X) {
    const int rows[8] = {0, 300, 5000, 9999, 16384, 20001, 30000, 32767}; const float* mod = (const float*)(X.ws + O_MOD);
    for (int it = X.bid * 512 + X.tid; it < 8 * 1024; it += X.G * 512) { const int ri = it >> 10, col = it & 1023; int m = 0;
#pragma unroll
        for (int q = 0; q < 8; ++q) if (q == ri) m = rows[q];
        float acc = 0.f; const bf16_t* y = (const bf16_t*)(X.ws + O_Y) + (size_t)m * 1024;
        for (int k = 0; k < 1024; ++k) acc += bf2f(y[k]) * X.in[19][(size_t)k * 1024 + col];
        const float want = X.in[0][(size_t)m * 1024 + col] + mod[(size_t)(m >> 12) * 6144 + 2048 + col] * acc;
        if (badcmp(X.out[(size_t)m * 1024 + col], want, 0.02f)) flag_fail(X.ws, 2);
    }
}
__device__ void diag_encode(const Ctx& X) {
    const unsigned* fl = (const unsigned*)(X.ws + O_FLAG); const int lo[5] = {0, 16384, 24576, 28672, 30720}, hi[5] = {16384, 24576, 28672, 30720, 31744};
#pragma unroll
    for (int k = 0; k < 5; ++k) if (fl[k]) for (size_t i = (size_t)lo[k] * 1024 + X.bid * 512 + X.tid; i < (size_t)hi[k] * 1024; i += (size_t)X.G * 512) X.out[i] = 0.f;
}
#endif

constexpr int LDS_BYTES = 160 * 1024;
__global__ void __launch_bounds__(512, 2) fwd_mega(Args args) {
    extern __shared__ __attribute__((aligned(16))) unsigned char lds_raw[];
    cg::grid_group grid = cg::this_grid();
    Ctx X; X.lds = (LAS unsigned char*)lds_raw; X.ws = args.ws; X.in = args.in; X.out = args.out;
    X.tid = threadIdx.x; X.lane = X.tid & 63; X.wave = __builtin_amdgcn_readfirstlane(X.tid >> 6); X.bid = blockIdx.x; X.G = gridDim.x;
    X.vcu = (X.G % 8 == 0) ? (X.bid % 8) * (X.G / 8) + X.bid / 8 : X.bid;
    volatile LAS unsigned* bst = (volatile LAS unsigned*)(X.lds + LDS_BYTES - 16);
    if (X.tid < 2) bst[X.tid] = 0u;
    __syncthreads();
    const XcdBarrier xbar = xcd_barrier_post((unsigned*)(X.ws + O_BAR), bst);
#define GSYNC() xcd_barrier(xbar)

    unsigned char* ws = X.ws; const float* mod = (const float*)(ws + O_MOD);
    typedef pg8::LinearOrder LO;
#ifdef DIAG
    if (X.bid == 0 && X.tid < 8) ((unsigned*)(X.ws + O_FLAG))[X.tid] = 0u;
#endif
    REPEAT(1) { p0_mod(X);
    p0_weights(X); __syncthreads(); }
    if (args.ws == nullptr) grid.sync();
    wait_mod(X);
    REPEAT(2) p1_norm(X);
    GSYNC();
    REPEAT(4) { pg8::Gemm g{(const bf16_t*)(ws + O_HN), (const bf16_t*)(ws + O_WIN), 1024}; pg8::InOrder S{X.G, X.vcu};
      EpiIn E{(bf16_t*)(ws + O_PQ), (bf16_t*)(ws + O_PKV), (bf16_t*)(ws + O_PX), (bf16_t*)(ws + O_GG), (float*)(ws + O_SSQQ), (float*)(ws + O_SSQKV)};
      pg8::gemm_phase<EpiIn, pg8::InOrder, pg8::RowsIdent, true>(X.lds, g, S, E, pg8::RowsIdent{}); }
    { constexpr int NU = 128 * 6 + 8 * 3; const int maxu = (NU + X.G - 1) / X.G, first = NU - (maxu - 1) * X.G;
      if (first >= X.G) convert_experts(X, X.vcu * 8 + X.wave, X.G * 8); else if (X.vcu >= first) convert_experts(X, (X.vcu - first) * 8 + X.wave, (X.G - first) * 8); }
    GSYNC();
    REPEAT(8) { pg8::Gemm g{(const bf16_t*)(ws + O_PQ), (const bf16_t*)(ws + O_WQ), 256}; LO S{TL / 256, 3, X.G, X.vcu};
      EpiQ E{(bf16_t*)(ws + O_Q), (const float*)(ws + O_SSQQ), (const float*)(ws + O_ROPE)};
      pg8::gemm_phase<EpiQ, LO, pg8::RowsIdent, true>(X.lds, g, S, E, pg8::RowsIdent{}); }
    REPEAT(8) { pg8::Gemm g{(const bf16_t*)(ws + O_PKV), (const bf16_t*)(ws + O_WKV), 256}; LO S{TA / 256, 4, X.G, X.vcu};
      EpiKV E{(bf16_t*)(ws + O_K), (bf16_t*)(ws + O_V), (const float*)(ws + O_SSQKV)};
      pg8::gemm_phase<EpiKV, LO, pg8::RowsIdent, true>(X.lds, g, S, E, pg8::RowsIdent{}); }
    REPEAT(8) krope_job(X);
    REPEAT(16) lru_a_phase(X);
    GSYNC();
    REPEAT(32) attn_phase(X);
    REPEAT(16) lru_c_phase(X);
    GSYNC();
    REPEAT(4) { pg8::Gemm g{(const bf16_t*)(ws + O_Y), (const bf16_t*)(ws + O_WO), 1024}; LO S{TL / 256, 4, X.G, X.vcu};
      EpiOut E{X.in[0], X.out, mod};
      pg8::gemm_phase<EpiOut, LO, pg8::RowsIdent, true>(X.lds, g, S, E, pg8::RowsIdent{}); }
    GSYNC();
#ifdef DIAG
    chk_p(X); chk_lru_scan(X); chk_x1(X);
    GSYNC();
    chk_lru_cmp(X);
    GSYNC();
#endif
    for (int xb_ = 0; xb_ < ((REP & 8192) ? 10 : 0); ++xb_) GSYNC();
    REPEAT(64) m0_phase(X, 0);
    GSYNC();
    REPEAT(256) m2_phase(X);
    GSYNC();
    for (int half = 0; half < 2; ++half) {
        REPEAT(128) { const bf16_t* F = half == 0 ? (const bf16_t*)(ws + O_YS) : (const bf16_t*)(ws + O_F1);
          pg8::Gemm g{F, (const bf16_t*)(ws + O_WGU), 1024}; MoeOrder S{(const int*)(ws + O_CNT), half, 2, X.G, X.vcu};
          LAS int* tab = (LAS int*)(X.lds + 131072); moe_rows_preload(X, S, tab);
          EpiHid E{(bf16_t*)(ws + O_HID)};
          pg8::gemm_phase<EpiHid, MoeOrder, RowsGather, true>(X.lds, g, S, E, RowsGather{tab}); }
        GSYNC();
        REPEAT(1024) { pg8::Gemm g{(const bf16_t*)(ws + O_HID), (const bf16_t*)(ws + O_WD), 256}; MoeOrder S{(const int*)(ws + O_CNT), half, 4, X.G, X.vcu};
          LAS int* tab2 = (LAS int*)(X.lds + 131072); moe_dst_preload(X, S, tab2);
          EpiDown E{ws + O_YS, tab2, X.out, mod, half, rep_};
          pg8::gemm_phase<EpiDown, MoeOrder, pg8::RowsIdent, true>(X.lds, g, S, E, pg8::RowsIdent{}); }
        GSYNC();
        if (REP & 2048) combine_phase(X, half, 1);
        combine_phase(X, half);
    }
#ifdef DIAG
    GSYNC();
    diag_encode(X);
#endif
}

extern "C" void kernel_launch(void* const* d_in, const int* in_sizes, int n_in, void* d_out, int out_size, void* d_ws, size_t ws_size, hipStream_t stream) {
    static int grid = 0;
    if (grid == 0) {
        if (n_in != 30 || out_size != TL * D_ || ws_size < WS_NEED) { fprintf(stderr, "kernel_launch: unexpected shapes n_in %d out %d ws %zu\n", n_in, out_size, ws_size); grid = -1; return; }
        int dev = 0, cus = 0, per_cu = 0;
        (void)hipGetDevice(&dev); (void)hipDeviceGetAttribute(&cus, hipDeviceAttributeMultiprocessorCount, dev);
        (void)hipFuncSetAttribute((const void*)fwd_mega, hipFuncAttributeMaxDynamicSharedMemorySize, LDS_BYTES);
        (void)hipOccupancyMaxActiveBlocksPerMultiprocessor(&per_cu, (const void*)fwd_mega, 512, LDS_BYTES);
        if (per_cu < 1) { fprintf(stderr, "kernel_launch: occupancy query says %d blocks per CU\n", per_cu); grid = -1; return; }
        grid = cus;
        fprintf(stderr, "kernel_launch: grid %d (cus %d, per_cu %d), ws %zu\n", grid, cus, per_cu, ws_size);
    }
    if (grid < 0) return;
    (void)hipMemsetAsync((unsigned char*)d_ws + O_BAR, 0, 32768, stream);
    Args a{};
    for (int i = 0; i < 30; ++i) a.in[i] = (const float*)d_in[i];
    a.out = (float*)d_out; a.ws = (unsigned char*)d_ws;
    void* params[] = {&a};
    hipError_t e = hipLaunchCooperativeKernel((const void*)fwd_mega, dim3(grid), dim3(512), params, LDS_BYTES, stream);
    if (e != hipSuccess) fprintf(stderr, "kernel_launch: cooperative launch failed: %s\n", hipGetErrorString(e));
}
```
